# Optimizing an MI355X kernel written in HIP

```python
import jax, jax.numpy as jnp
from jax import lax
import numpy as np


D_MODEL = 1024
BATCH = 16
SEQ = 256
DEPTH = 4
DEC_BATCH = 8
DEC_SEQ = 1024
PAST_LEN = 256

GRID_W = 64
N_HEADS = 8
N_KV_HEADS = 2
HEAD_DIM = 64
GQA_GROUP = N_HEADS // N_KV_HEADS
ATTN_W = N_HEADS * HEAD_DIM
KV_W = N_KV_HEADS * HEAD_DIM
POOL_WINDOWS = (2, 4, 8, 16)
N_POOL_GROUPS = 4
POOL_W = D_MODEL // 2
POOL_GROUP_W = POOL_W // N_POOL_GROUPS
MIX_W = ATTN_W + POOL_W
IN_W = ATTN_W + 2 * KV_W + POOL_W
D_FF = 2816
CONV_W = 3
WINDOW = 128
BLOCK = 128
ROPE_BASE = 10000.0
LN_EPS = 1e-5
DEEPNORM_ALPHA = (2 * DEPTH) ** 0.25
DEEPNORM_BETA = (8 * DEPTH) ** -0.25
ATTN_SCALE = HEAD_DIM ** -0.5
NEG_INF = -1e30

kernel_name = 'hybrid_pool_swa_prefix_dit_step'


def _layer_norm(x, g, b):
    xf = x.astype(jnp.float32)
    mu = jnp.mean(xf, axis=-1, keepdims=True)
    var = jnp.mean(jnp.square(xf - mu), axis=-1, keepdims=True)
    y = (xf - mu) * lax.rsqrt(var + LN_EPS) * g.astype(jnp.float32) + b.astype(jnp.float32)
    return y.astype(x.dtype)


def _modulation(cond, w_mod, b_mod):
    return jnp.split(jax.nn.silu(cond) @ w_mod + b_mod, 6, axis=-1)


def _project(h, w_in):
    B, T, _ = h.shape
    q, k, v, p = jnp.split(h @ w_in, [ATTN_W, ATTN_W + KV_W, ATTN_W + 2 * KV_W], axis=-1)
    q = q.reshape(B, T, N_HEADS, HEAD_DIM)
    k = k.reshape(B, T, N_KV_HEADS, HEAD_DIM)
    v = v.reshape(B, T, N_KV_HEADS, HEAD_DIM)
    return q, k, v, p


def _axial_rope(x):
    T = x.shape[1]
    rows = T // GRID_W
    row = jnp.repeat(jnp.arange(rows), GRID_W)
    col = jnp.tile(jnp.arange(GRID_W), rows)
    half = HEAD_DIM // 2
    inv_freq = ROPE_BASE ** (-jnp.arange(0, half, 2, dtype=jnp.float32) / half)

    def rotate(xa, pos):
        ang = pos.astype(jnp.float32)[:, None] * inv_freq[None, :]
        ang = jnp.concatenate([ang, ang], axis=-1)[None, :, None, :]
        cos = jnp.cos(ang).astype(x.dtype)
        sin = jnp.sin(ang).astype(x.dtype)
        x1, x2 = jnp.split(xa, 2, axis=-1)
        return xa * cos + jnp.concatenate([-x2, x1], axis=-1) * sin

    return jnp.concatenate([rotate(x[..., :half], row), rotate(x[..., half:], col)], axis=-1)


def _attend(q, k, v, sink, bias):
    s = jnp.einsum('bqhgd,bkhd->bhgqk', q, k).astype(jnp.float32) * ATTN_SCALE
    if bias is not None:
        s = s + bias
    sink_col = jnp.broadcast_to(sink.astype(jnp.float32)[None, :, :, None, None], s.shape[:-1] + (1,))
    p = jax.nn.softmax(jnp.concatenate([sink_col, s], axis=-1), axis=-1)[..., 1:]
    return jnp.einsum('bhgqk,bkhd->bqhgd', p.astype(v.dtype), v)


def _context_attention(q, k, v, sink):
    B, T = q.shape[:2]
    nb = T // BLOCK
    qb = jnp.moveaxis(q.reshape(B, nb, BLOCK, N_KV_HEADS, GQA_GROUP, HEAD_DIM), 1, 0)
    sk = sink.reshape(N_KV_HEADS, GQA_GROUP)
    out = lax.map(lambda qi: _attend(qi, k, v, sk, None), qb)
    return jnp.moveaxis(out, 0, 1).reshape(B, T, ATTN_W)


def _latent_attention(q, k, v, k_ctx, v_ctx, sink):
    B, T = q.shape[:2]
    nb = T // BLOCK
    Lc = k_ctx.shape[1]
    qg = q.reshape(B, T, N_KV_HEADS, GQA_GROUP, HEAD_DIM)
    pad = ((0, 0), (BLOCK, BLOCK), (0, 0), (0, 0))
    kp = jnp.pad(k, pad)
    vp = jnp.pad(v, pad)
    sk = sink.reshape(N_KV_HEADS, GQA_GROUP)
    r = jnp.arange(BLOCK)[:, None]
    cidx = jnp.arange(3 * BLOCK)[None, :]
    ctx_bias = jnp.zeros((BLOCK, Lc), jnp.float32)

    def block(i):
        qi = lax.dynamic_slice_in_dim(qg, i * BLOCK, BLOCK, axis=1)
        ki = lax.dynamic_slice_in_dim(kp, i * BLOCK, 3 * BLOCK, axis=1)
        vi = lax.dynamic_slice_in_dim(vp, i * BLOCK, 3 * BLOCK, axis=1)
        qpos = i * BLOCK + r
        kpos = (i - 1) * BLOCK + cidx
        valid = (jnp.abs(qpos - kpos) <= WINDOW) & (kpos >= 0) & (kpos < T)
        bias = jnp.concatenate([ctx_bias, jnp.where(valid, 0.0, NEG_INF).astype(jnp.float32)], axis=1)
        kk = jnp.concatenate([k_ctx.astype(ki.dtype), ki], axis=1)
        vv = jnp.concatenate([v_ctx.astype(vi.dtype), vi], axis=1)
        return _attend(qi, kk, vv, sk, bias)

    out = lax.map(block, jnp.arange(nb))
    return jnp.moveaxis(out, 0, 1).reshape(B, T, ATTN_W)


def _pool_mixer(p, w_pool, pool_scale):
    B, T, _ = p.shape
    pf = p.astype(jnp.float32).reshape(B, T, N_POOL_GROUPS, POOL_GROUP_W)
    cs = jnp.pad(jnp.cumsum(pf, axis=1), ((0, 0), (1, 0), (0, 0), (0, 0)))
    t = jnp.arange(T)[:, None]
    win = jnp.array(POOL_WINDOWS, dtype=jnp.int32)[None, :]
    start = jnp.maximum(t - win // 2, 0)
    end = jnp.minimum(t + win - win // 2, T)
    grp = jnp.arange(N_POOL_GROUPS)[None, :]
    total = cs[:, end, grp] - cs[:, start, grp]
    mean = total / (end - start).astype(jnp.float32)[None, :, :, None]
    d = (mean - pf).astype(p.dtype)
    y = jnp.einsum('btgc,gcd->btgd', d, w_pool).reshape(B, T, POOL_W)
    return y * pool_scale


def _conv_ffn(h, w_up, conv_w, conv_b, w_down):
    T = h.shape[1]
    u = h @ w_up
    up = jnp.pad(u, ((0, 0), (1, 1), (0, 0)))
    u = up[:, :T] * conv_w[0] + up[:, 1:T + 1] * conv_w[1] + up[:, 2:] * conv_w[2] + conv_b
    a, g = jnp.split(u, 2, axis=-1)
    return (jax.nn.silu(g) * a) @ w_down


def _trunk_layer(x, mods, attend, w_in, w_pool, pool_scale, w_out, ln1_g, ln1_b,
                 w_up, conv_w, conv_b, w_down, ln2_g, ln2_b):
    sh1, sc1, g1, sh2, sc2, g2 = mods
    h = x * (1.0 + sc1) + sh1
    q, k, v, p = _project(h, w_in)
    attn = attend(q, k, v)
    pool = _pool_mixer(p, w_pool, pool_scale)
    mix = jnp.concatenate([attn, pool], axis=-1) @ w_out
    x = _layer_norm(DEEPNORM_ALPHA * x + g1 * mix, ln1_g, ln1_b)
    h = x * (1.0 + sc2) + sh2
    ff = _conv_ffn(h, w_up, conv_w, conv_b, w_down)
    x = _layer_norm(DEEPNORM_ALPHA * x + g2 * ff, ln2_g, ln2_b)
    return x, k, v


def setup_inputs(seed: int = 0) -> dict:
    key = jax.random.key(seed)
    ks = jax.random.split(key, 24)
    f32 = jnp.float32

    def nrm(k, shape, scale):
        return jax.random.normal(k, shape, f32) * scale

    x_prompt = nrm(ks[0], (BATCH, SEQ, D_MODEL), 1.0)
    x_sample = nrm(ks[1], (DEC_BATCH, DEC_SEQ, D_MODEL), 1.0)
    cache_k = nrm(ks[2], (DEC_BATCH, DEPTH, PAST_LEN, N_KV_HEADS, HEAD_DIM), 1.0)
    cache_v = nrm(ks[3], (DEC_BATCH, DEPTH, PAST_LEN, N_KV_HEADS, HEAD_DIM), DEEPNORM_BETA)
    c = nrm(ks[4], (DEC_BATCH, D_MODEL), 1.0)
    c_ctx = nrm(ks[5], (D_MODEL,), 1.0)
    w_mod = nrm(ks[6], (DEPTH, D_MODEL, 6 * D_MODEL), 0.5 * D_MODEL ** -0.5)
    b_mod = nrm(ks[7], (DEPTH, 6 * D_MODEL), 0.01)
    cols = jnp.arange(IN_W)
    v_cols = (cols >= ATTN_W + KV_W) & (cols < ATTN_W + 2 * KV_W)
    w_in = nrm(ks[8], (DEPTH, D_MODEL, IN_W), D_MODEL ** -0.5) * jnp.where(v_cols, DEEPNORM_BETA, 1.0)
    attn_sink = nrm(ks[9], (DEPTH, N_HEADS), 0.5)
    w_pool = nrm(ks[10], (DEPTH, N_POOL_GROUPS, POOL_GROUP_W, POOL_GROUP_W), POOL_GROUP_W ** -0.5)
    pool_scale = 1.0 + nrm(ks[11], (DEPTH, POOL_W), 0.1)
    w_out = nrm(ks[12], (DEPTH, MIX_W, D_MODEL), DEEPNORM_BETA * MIX_W ** -0.5)
    ln1_g = 1.0 + nrm(ks[13], (DEPTH, D_MODEL), 0.05)
    ln1_b = nrm(ks[14], (DEPTH, D_MODEL), 0.02)
    w_up = nrm(ks[15], (DEPTH, D_MODEL, 2 * D_FF), D_MODEL ** -0.5)
    conv_w = jnp.array([0.0, 1.0, 0.0], f32)[None, :, None] + nrm(ks[16], (DEPTH, CONV_W, 2 * D_FF), 0.3)
    conv_b = nrm(ks[17], (DEPTH, 2 * D_FF), 0.02)
    w_down = nrm(ks[18], (DEPTH, D_FF, D_MODEL), DEEPNORM_BETA * D_FF ** -0.5)
    ln2_g = 1.0 + nrm(ks[19], (DEPTH, D_MODEL), 0.05)
    ln2_b = nrm(ks[20], (DEPTH, D_MODEL), 0.02)
    return {'x_prompt': x_prompt, 'x_sample': x_sample, 'cache_k': cache_k, 'cache_v': cache_v,
            'c': c, 'c_ctx': c_ctx, 'w_mod': w_mod, 'b_mod': b_mod, 'w_in': w_in,
            'attn_sink': attn_sink, 'w_pool': w_pool, 'pool_scale': pool_scale, 'w_out': w_out,
            'ln1_g': ln1_g, 'ln1_b': ln1_b, 'w_up': w_up, 'conv_w': conv_w, 'conv_b': conv_b,
            'w_down': w_down, 'ln2_g': ln2_g, 'ln2_b': ln2_b}


def reference(x_prompt, x_sample, cache_k, cache_v, c, c_ctx, w_mod, b_mod, w_in, attn_sink,
              w_pool, pool_scale, w_out, ln1_g, ln1_b, w_up, conv_w, conv_b, w_down, ln2_g, ln2_b):
    x = x_prompt
    ks, vs = [], []
    for l in range(DEPTH):
        mods = _modulation(c_ctx, w_mod[l], b_mod[l])
        sink_l = attn_sink[l]
        attend = lambda q, k, v, s=sink_l: _context_attention(q, k, v, s)
        x, k, v = _trunk_layer(x, mods, attend, w_in[l], w_pool[l], pool_scale[l], w_out[l],
                               ln1_g[l], ln1_b[l], w_up[l], conv_w[l], conv_b[l], w_down[l],
                               ln2_g[l], ln2_b[l])
        ks.append(k)
        vs.append(v)
    y_prompt = x
    new_cache_k = jnp.stack(ks, axis=1)
    new_cache_v = jnp.stack(vs, axis=1)

    x = x_sample
    for l in range(DEPTH):
        mods = [m[:, None, :] for m in _modulation(c, w_mod[l], b_mod[l])]
        sink_l = attn_sink[l]
        kc = cache_k[:, l]
        vc = cache_v[:, l]
        attend = lambda q, k, v, s=sink_l, kc=kc, vc=vc: _latent_attention(
            _axial_rope(q), _axial_rope(k), v, kc, vc, s)
        x, _, _ = _trunk_layer(x, mods, attend, w_in[l], w_pool[l], pool_scale[l], w_out[l],
                               ln1_g[l], ln1_b[l], w_up[l], conv_w[l], conv_b[l], w_down[l],
                               ln2_g[l], ln2_b[l])
    y_sample = x
    return (y_prompt, y_sample, new_cache_k, new_cache_v)
```

```cpp
#include <hip/hip_runtime.h>
#include <hip/hip_cooperative_groups.h>
#include <cstdio>
#include <cstdint>
namespace cg = cooperative_groups;

#define LAS __attribute__((address_space(3)))
typedef unsigned short bf16_t;
typedef short bf16x8 __attribute__((ext_vector_type(8)));
typedef short s16x4 __attribute__((ext_vector_type(4)));
typedef float f32x2 __attribute__((ext_vector_type(2)));
typedef float f32x4 __attribute__((ext_vector_type(4)));
typedef float f32x16 __attribute__((ext_vector_type(16)));
typedef unsigned u32x2 __attribute__((ext_vector_type(2)));
typedef unsigned u32x4 __attribute__((ext_vector_type(4)));
typedef int i32x4 __attribute__((ext_vector_type(4)));
typedef int i32x8 __attribute__((ext_vector_type(8)));

constexpr int D = 1024, DEPTH = 4, NCTX = 16, SEQ = 256, NLAT = 8, LSEQ = 1024, PAST = 256;
constexpr int MCTX = NCTX * SEQ, MTOT = MCTX + NLAT * LSEQ;
constexpr int INW = 1280, DFF = 2816, UPW = 2 * DFF;
constexpr int NCOND = 9, MODW = 6 * D;
constexpr float LN_EPS = 1e-5f;
constexpr float ALPHA = 1.681792830507429f;
constexpr float QSCALE = 0.125f * 1.4426950408889634f;
constexpr float LOG2E = 1.4426950408889634f;
constexpr bool OUT_FP8 = true;
constexpr bool DOWN_FP8 = true;
constexpr bool UP_FP8 = false;
constexpr float S_WUP = UP_FP8 ? 64.f : 1.f, S_WDN = DOWN_FP8 ? 256.f : 1.f, S_ACT = DOWN_FP8 ? 8.f : 1.f, S_WOUT = OUT_FP8 ? 64.f : 1.f, S_MIX = OUT_FP8 ? 16.f : 1.f;

constexpr size_t MiB = 1u << 20;
constexpr size_t WS_WIN = 0, WS_WOUT = 10 * MiB, WS_WUP = 18 * MiB, WS_WDN = 62 * MiB, WS_MODS = 84 * MiB, WS_ROPE = 85 * MiB;
constexpr size_t WS_STATS = 85 * MiB + 64 * 1024;
constexpr size_t WS_BAR = 84 * MiB + 900 * 1024;
constexpr size_t WS_KC = 86 * MiB, WS_VCT = 88 * MiB, WS_X = 90 * MiB, WS_H = 138 * MiB;
constexpr size_t WS_Q = 162 * MiB, WS_K = 174 * MiB, WS_VT = 177 * MiB, WS_PP = 180 * MiB, WS_MIX = 204 * MiB;
constexpr size_t WS_HALO = 228 * MiB;
constexpr size_t WS_ACT = 234 * MiB, WS_H8 = 300 * MiB, WS_END = 312 * MiB;
constexpr int VT_LAT_OFF = NCTX * 128 * SEQ;

constexpr int LDS_BYTES = 147456;

struct Params { const float* in[21]; float* out; unsigned char* ws; };
__device__ __forceinline__ const float* inp(const Params& p, int i) { asm volatile("" : "+s"(i)); return (const float*)(const __attribute__((address_space(1))) float*)p.in[i]; }
enum { I_XP = 0, I_XS, I_CK, I_CV, I_C, I_CCTX, I_WMOD, I_BMOD, I_WIN, I_SINK, I_WPOOL, I_PSCALE, I_WOUT, I_LN1G, I_LN1B, I_WUP, I_CONVW, I_CONVB, I_WDOWN, I_LN2G, I_LN2B };

__device__ __forceinline__ unsigned f2bf(float f) { unsigned u = __builtin_bit_cast(unsigned, f); return (u + 0x7fffu + ((u >> 16) & 1u)) >> 16; }
__device__ __forceinline__ unsigned pk2(float lo, float hi) { return f2bf(lo) | (f2bf(hi) << 16); }
__device__ __forceinline__ unsigned pk4_fp8(float a, float b, float c, float d) { int w = 0; w = __builtin_amdgcn_cvt_pk_fp8_f32(a, b, w, false); w = __builtin_amdgcn_cvt_pk_fp8_f32(c, d, w, true); return (unsigned)w; }
__device__ __forceinline__ float bf2f(unsigned short v) { return __builtin_bit_cast(float, (unsigned)v << 16); }
__device__ __forceinline__ float bflo(unsigned v) { return __builtin_bit_cast(float, v << 16); }
__device__ __forceinline__ float bfhi(unsigned v) { return __builtin_bit_cast(float, v & 0xffff0000u); }
#define LDS_WAIT() asm volatile("s_waitcnt lgkmcnt(0)" ::: "memory")
__device__ __forceinline__ float shfl_xor_l(float v, int lane, int m) { return __builtin_bit_cast(float, __builtin_amdgcn_ds_bpermute((lane ^ m) << 2, __builtin_bit_cast(int, v))); }
__device__ __forceinline__ float wave_sum(float v) {
#pragma unroll
    for (int o = 1; o < 64; o <<= 1) v += __shfl_xor(v, o);
    return v;
}
__device__ __forceinline__ int lane_id() { int r; asm volatile("v_mbcnt_lo_u32_b32 %0, -1, 0\n\tv_mbcnt_hi_u32_b32 %0, -1, %0" : "=v"(r)); return r; }
#define TID(wv) ((wv) * 64 + lane_id())
__device__ __forceinline__ int cond_of_row(int row) { return row < MCTX ? 0 : 1 + ((row - MCTX) >> 10); }

namespace pg8 {
constexpr int BM = 256, BK = 64, HALF = 128, HTB = HALF * BK * 2, NXCD = 8, WGM = 6;
__device__ __forceinline__ int lds_byte(int r, int c) { const int st = (r >> 4) * 2 + (c >> 5), rr = r & 15, cc = c & 31, ob = rr * 64 + cc * 2; return st * 1024 + (ob ^ (((ob >> 9) & 1) << 5)); }
__device__ __forceinline__ void stage_rc(int b, int& R, int& C) { const int st = b / 1024, sb = b % 1024, swz = sb ^ (((sb >> 9) & 1) << 5); R = (st >> 1) * 16 + swz / 64; C = (st & 1) * 32 + (swz % 64) / 2; }
__device__ __forceinline__ int perm32(int rho) { const int n = rho >> 4, i = rho & 15; return 8 * (i >> 2) + 4 * n + (i & 3); }
struct Unit { int pm, pn; };
struct Gemm { const bf16_t* A; const bf16_t* Bt; int M, N, K; };
struct StaticOrder {
    int nM, nN, nwg, G, c;
    __device__ void init(int M, int N, int G_, int c_) { nM = M / BM; nN = N / BM; nwg = nM * nN; G = G_; c = c_; }
    __device__ bool next(int i, Unit& u) const {
        const long L = (long)i * G + c; if (L >= nwg) return false;
        int wgid = (int)L; { const int q = nwg / NXCD, r = nwg % NXCD, xcd = wgid % NXCD, off = wgid / NXCD; wgid = (xcd < r ? xcd * (q + 1) : r * (q + 1) + (xcd - r) * q) + off; }
        const int nig = WGM * nN, gid = wgid / nig, fm = gid * WGM, gsz = (nM - fm) < WGM ? (nM - fm) : WGM;
        u.pm = fm + ((wgid % nig) % gsz); u.pn = (wgid % nig) / gsz; return true;
    }
};
__device__ __forceinline__ unsigned cvt_pk_bf16(float lo, float hi) { unsigned r; asm volatile("v_cvt_pk_bf16_f32 %0, %1, %2" : "=v"(r) : "v"(lo), "v"(hi)); return r; }

#define PG8_LANE_FROM_AOFF(aoff, fr, fq) int a__ = (aoff); asm volatile("" : "+v"(a__)); const int fr = (a__ >> 6) & 15, fq = ((a__ >> 4) & 3) ^ ((fr >> 3) << 1)
template <class Epi, class Sched>
__device__ __forceinline__ void gemm_phase(LAS unsigned char* lds, const Gemm g, const Sched& S, const Epi& E, int wv) {
    int tid_ = TID(wv); asm volatile("" : "+v"(tid_));
    const int tid = tid_, wid = __builtin_amdgcn_readfirstlane(tid >> 6), lane = tid & 63, wr = wid >> 2, wc = wid & 3, fr = lane & 15, fq = lane >> 4;
    const int K = g.K, nt = K / BK;
    unsigned voffA, voffB;
    { int R, C; stage_rc(tid * 16, R, C); const int Rb = Epi::PERM ? ((R & ~31) + perm32(R & 31)) : R;
      voffA = (unsigned)(R * K + C) * 2u; voffB = (unsigned)(Rb * K + C) * 2u; }
    const size_t rstep = (size_t)64 * K * 2;
    const size_t kstep = (size_t)(BK * 2);
    const size_t hstep = (size_t)HALF * K * 2;
    const size_t tstep = 2 * hstep;
    const unsigned ldsw = (unsigned)wid * 1024u;
    const int aoff = lds_byte(wr * 64 + fr, fq * 8), boff = lds_byte(wc * 32 + fr, fq * 8);
#define PG8_SA(b, h) (((b) * 2 + (h)) * HTB)
#define PG8_SB(b, h) ((4 + (b) * 2 + (h)) * HTB)
#define PG8_STAGE(bufoff, gbase, voff) do { _Pragma("unroll") for (int _i = 0; _i < 2; ++_i) \
        __builtin_amdgcn_global_load_lds((const unsigned*)((const char*)(gbase) + _i * rstep + (voff)), (LAS unsigned*)(lds + (bufoff) + ldsw + _i * 8192), 16, 0, 0); } while (0)
#define PG8_CAT(x, y) __builtin_shufflevector(__builtin_bit_cast(i32x4, x), __builtin_bit_cast(i32x4, y), 0, 1, 2, 3, 4, 5, 6, 7)
#define PG8_LDA(dst, b, h) do { if constexpr (Epi::FP8) { _Pragma("unroll") for (int m = 0; m < 4; ++m) dst##8[m] = PG8_CAT(*(const LAS bf16x8*)(lds + PG8_SA(b, h) + aoff + m * 2048), *(const LAS bf16x8*)(lds + PG8_SA(b, h) + aoff + m * 2048 + 1024)); } \
        else { _Pragma("unroll") for (int m = 0; m < 4; ++m) _Pragma("unroll") for (int k = 0; k < 2; ++k) dst[m][k] = *(const LAS bf16x8*)(lds + PG8_SA(b, h) + aoff + m * 2048 + k * 1024); } } while (0)
#define PG8_LDB(dst, b, h) do { if constexpr (Epi::FP8) { _Pragma("unroll") for (int n = 0; n < 2; ++n) dst##8[n] = PG8_CAT(*(const LAS bf16x8*)(lds + PG8_SB(b, h) + boff + n * 2048), *(const LAS bf16x8*)(lds + PG8_SB(b, h) + boff + n * 2048 + 1024)); } \
        else { _Pragma("unroll") for (int n = 0; n < 2; ++n) _Pragma("unroll") for (int k = 0; k < 2; ++k) dst[n][k] = *(const LAS bf16x8*)(lds + PG8_SB(b, h) + boff + n * 2048 + k * 1024); } } while (0)
#define PG8_MMA(ai, bj, At, Bt) do { __builtin_amdgcn_s_setprio(1); \
        if constexpr (Epi::FP8) { _Pragma("unroll") for (int m = 0; m < 4; ++m) _Pragma("unroll") for (int n = 0; n < 2; ++n) \
            acc[ai][bj][m][n] = __builtin_amdgcn_mfma_scale_f32_16x16x128_f8f6f4(Bt##8[n], At##8[m], acc[ai][bj][m][n], 0, 0, 0, 0x7f7f7f7f, 0, 0x7f7f7f7f); } \
        else { _Pragma("unroll") for (int m = 0; m < 4; ++m) _Pragma("unroll") for (int n = 0; n < 2; ++n) _Pragma("unroll") for (int k = 0; k < 2; ++k) \
            acc[ai][bj][m][n] = __builtin_amdgcn_mfma_f32_16x16x32_bf16(Bt[n][k], At[m][k], acc[ai][bj][m][n], 0, 0, 0); } \
        __builtin_amdgcn_s_setprio(0); } while (0)
#define PG8_WAIT_V(n) asm volatile("s_waitcnt vmcnt(" #n ")" ::: "memory")
#define PG8_WAIT_L(n) asm volatile("s_waitcnt lgkmcnt(" #n ")" ::: "memory")
#define PG8_BAR __builtin_amdgcn_s_barrier()
#define PG8_SCHED __builtin_amdgcn_sched_barrier(0)
    Unit cur, nxt; int ui = 0;
    if (!S.next(0, cur)) return;
    f32x4 acc[2][2][4][2];
#pragma unroll
    for (int a = 0; a < 2; ++a)
#pragma unroll
        for (int b = 0; b < 2; ++b)
#pragma unroll
            for (int m = 0; m < 4; ++m)
#pragma unroll
                for (int n = 0; n < 2; ++n) acc[a][b][m][n] = (f32x4){0.f, 0.f, 0.f, 0.f};
    bf16x8 At[4][2], B0[2][2], B1[2][2];
    i32x8 At8[4], B08[2], B18[2];
    const char* cA = (const char*)g.A + (size_t)cur.pm * tstep; const char* cB = (const char*)g.Bt + (size_t)cur.pn * tstep;
    PG8_STAGE(PG8_SB(0, 0), cB, voffB); PG8_STAGE(PG8_SB(0, 1), cB + hstep, voffB); PG8_STAGE(PG8_SA(0, 0), cA, voffA); PG8_STAGE(PG8_SA(0, 1), cA + hstep, voffA);
    if (wr == 1) PG8_BAR;
    PG8_WAIT_V(2); PG8_BAR;
    PG8_STAGE(PG8_SB(1, 0), cB + kstep, voffB); PG8_STAGE(PG8_SA(1, 0), cA + kstep, voffA); PG8_STAGE(PG8_SB(1, 1), cB + hstep + kstep, voffB);
    PG8_WAIT_V(6); PG8_BAR;
    for (;;) {
        const bool has_next = Epi::LNF ? false : S.next(ui + 1, nxt);
        const char* nA = has_next ? (const char*)g.A + (size_t)nxt.pm * tstep : cA; const char* nB = has_next ? (const char*)g.Bt + (size_t)nxt.pn * tstep : cB;
#pragma unroll 1
        for (int t = 0; t < nt; t += 2) {
            const bool last = (t == nt - 2);
            const char* a1 = cA + (size_t)(t + 1) * kstep;
            const char* a2 = last ? nA : cA + (size_t)(t + 2) * kstep; const char* b2 = last ? nB : cB + (size_t)(t + 2) * kstep;
            asm volatile("" : "+s"(a1), "+s"(a2), "+s"(b2));
            const char* a3 = a2 + kstep; const char* b3 = b2 + kstep;
            PG8_LDB(B0, 0, 0); PG8_LDB(B1, 0, 1); PG8_SCHED; PG8_LDA(At, 0, 0); PG8_STAGE(PG8_SA(1, 1), a1 + hstep, voffA);
            PG8_WAIT_V(8); PG8_WAIT_L(0); PG8_BAR; PG8_MMA(0, 0, At, B0); PG8_MMA(0, 1, At, B1); PG8_BAR; PG8_SCHED;
            PG8_LDA(At, 0, 1); PG8_STAGE(PG8_SB(0, 0), b2, voffB); PG8_STAGE(PG8_SB(0, 1), b2 + hstep, voffB); PG8_STAGE(PG8_SA(0, 0), a2, voffA);
            PG8_WAIT_V(8); PG8_WAIT_L(0); PG8_BAR; PG8_MMA(1, 0, At, B0); PG8_MMA(1, 1, At, B1); PG8_BAR; PG8_SCHED;
            PG8_LDB(B0, 1, 0); PG8_LDB(B1, 1, 1); PG8_SCHED; PG8_LDA(At, 1, 0); PG8_STAGE(PG8_SA(0, 1), a2 + hstep, voffA);
            PG8_WAIT_V(8); PG8_WAIT_L(0); PG8_BAR; PG8_MMA(0, 0, At, B0); PG8_MMA(0, 1, At, B1); PG8_BAR; PG8_SCHED;
            PG8_LDA(At, 1, 1); PG8_STAGE(PG8_SB(1, 0), b3, voffB); PG8_STAGE(PG8_SB(1, 1), b3 + hstep, voffB); PG8_STAGE(PG8_SA(1, 0), a3, voffA);
            PG8_WAIT_V(8); PG8_WAIT_L(0); PG8_BAR; PG8_MMA(1, 0, At, B0); PG8_MMA(1, 1, At, B1); PG8_BAR; PG8_SCHED;
        }
        if constexpr (Epi::LNF) break;
        if constexpr (Epi::ALIGN) { if (wr == 0) PG8_BAR; E.pre(acc, cur, wr, wc, aoff); PG8_WAIT_L(0); PG8_BAR; }
        E(acc, cur, wr, wc, aoff);
        if (!has_next) break;
#pragma unroll
        for (int a = 0; a < 2; ++a)
#pragma unroll
            for (int b = 0; b < 2; ++b)
#pragma unroll
                for (int m = 0; m < 4; ++m)
#pragma unroll
                    for (int n = 0; n < 2; ++n) acc[a][b][m][n] = (f32x4){0.f, 0.f, 0.f, 0.f};
        cur = nxt; cA = nA; cB = nB; ++ui;
        if constexpr (Epi::ALIGN) { if (wr == 1) PG8_BAR; }
    }
    PG8_WAIT_V(0);
    if constexpr (!Epi::ALIGN) { if (wr == 0) PG8_BAR; }
    PG8_BAR;
    if constexpr (Epi::LNF) E.fused(acc, cur, wr, wc, aoff);
#undef PG8_SA
#undef PG8_SB
#undef PG8_STAGE
#undef PG8_LDA
#undef PG8_LDB
#undef PG8_MMA
#undef PG8_CAT
#undef PG8_WAIT_V
#undef PG8_WAIT_L
#undef PG8_BAR
#undef PG8_SCHED
}
}

#define XB_TMO      128
#define XB_XCNT(j)  (256  + 64 * (j))
#define XB_XSUB(j)  (1280 + 64 * (j))
#define XB_XGEN(j)  (2304 + 64 * (j))
#define XB_TOP      3328
#define XB_TOPGEN   3392
#define XCD_BAR_WORDS 3456
#define XB_SPIN_CAP (1u << 18)
__device__ __forceinline__ unsigned xb_ld(unsigned* p)              { return __hip_atomic_load(p, __ATOMIC_RELAXED, __HIP_MEMORY_SCOPE_AGENT); }
__device__ __forceinline__ unsigned xb_add(unsigned* p, unsigned v) { return __hip_atomic_fetch_add(p, v, __ATOMIC_RELAXED, __HIP_MEMORY_SCOPE_AGENT); }
__device__ __forceinline__ unsigned xb_xcc_id() { return (unsigned)__builtin_amdgcn_s_getreg((3 << 11) | 20) & 0xFu; }
#define XB_SPIN(cond, bar) do { unsigned _sp = 0; while (cond) { __builtin_amdgcn_s_sleep(0); \
    if ((++_sp & 255u) == 0u) { if (xb_ld(&(bar)[XB_TMO])) break; if (_sp > XB_SPIN_CAP) { atomicAdd(&(bar)[XB_TMO], 1u); break; } } } } while (0)
__device__ __forceinline__ void xcd_barrier_post(unsigned* bar, int wv) {
    if (wv == 0 && lane_id() == 0) (void)xb_add(&bar[XB_XCNT(xb_xcc_id())], 1u);
}
__device__ __forceinline__ void xcd_barrier_complete(unsigned* bar, unsigned x, unsigned& nloc, unsigned& nx) {
    const unsigned G = gridDim.x * gridDim.y * gridDim.z;
    unsigned sum, cnt, sp = 0u;
    for (;;) {
        sum = 0u; cnt = 0u;
#pragma unroll 1
        for (unsigned j = 0; j < 16; ++j) { const unsigned c = xb_ld(&bar[XB_XCNT(j)]); sum += c; cnt += (c > 0u) ? 1u : 0u; }
        if (sum == G) break;
        __builtin_amdgcn_s_sleep(1);
        if ((++sp & 255u) == 0u) { if (xb_ld(&bar[XB_TMO])) break; if (sp > XB_SPIN_CAP) { atomicAdd(&bar[XB_TMO], 1u); break; } }
    }
    const unsigned mine = xb_ld(&bar[XB_XCNT(x)]);
    nloc = mine > 0u ? mine : 1u; nx = cnt > 0u ? cnt : 1u;
}
__device__ __forceinline__ void xcd_barrier_leader(unsigned* bar, volatile LAS unsigned* st) {
    const unsigned x = xb_xcc_id();
    __builtin_amdgcn_s_waitcnt(0);
    unsigned nloc = st[0], nx = st[1];
    if (nloc == 0u) { xcd_barrier_complete(bar, x, nloc, nx); st[0] = nloc; st[1] = nx; }
    const unsigned old = xb_add(&bar[XB_XSUB(x)], 1u);
    const unsigned gen = old / nloc;
    if (old + 1u == (gen + 1u) * nloc) {
        __builtin_amdgcn_fence(__ATOMIC_RELEASE, "agent");
        asm volatile("s_waitcnt vmcnt(0)" ::: "memory");
        const unsigned og = xb_add(&bar[XB_TOP], 1u);
        const unsigned tg = og / nx;
        if (og + 1u == (tg + 1u) * nx) xb_add(&bar[XB_TOPGEN], 1u);
        else XB_SPIN(xb_ld(&bar[XB_TOPGEN]) == tg, bar);
        __builtin_amdgcn_fence(__ATOMIC_ACQUIRE, "agent");
        xb_add(&bar[XB_XGEN(x)], 1u);
        asm volatile("s_waitcnt vmcnt(0)" ::: "memory");
    } else {
        XB_SPIN(xb_ld(&bar[XB_XGEN(x)]) == gen, bar);
        __builtin_amdgcn_fence(__ATOMIC_ACQUIRE, "agent");
        asm volatile("s_waitcnt vmcnt(0)" ::: "memory");
    }
}
__device__ __forceinline__ void xcd_barrier(unsigned* bar, volatile LAS unsigned* st, int wv) {
    asm volatile("s_waitcnt vmcnt(0)" ::: "memory");
    __syncthreads();
    if (wv == 0 && lane_id() == 0) xcd_barrier_leader(bar, st);
    __syncthreads();
}

struct EpiIn {
    static constexpr bool PERM = false, ALIGN = false, LNF = false, FP8 = false;
    int l; bf16_t *Q, *Kb, *VT; float* PP; const float* rope; float *outk, *outv;
    __device__ __forceinline__ void operator()(const f32x4 (&acc)[2][2][4][2], const pg8::Unit& u, int wr, int wc, int aoff) const {
        PG8_LANE_FROM_AOFF(aoff, fr, fq);
        const bool lat = u.pm >= 16;
#pragma unroll
        for (int ai = 0; ai < 2; ++ai)
#pragma unroll
            for (int m = 0; m < 4; ++m) {
                const int row = u.pm * 256 + ai * 128 + wr * 64 + m * 16 + fr;
                f32x4 c4 = {1.f, 1.f, 1.f, 1.f}, s4 = {0.f, 0.f, 0.f, 0.f};
                if (lat && u.pn <= 2) {
                    const int t = (row - MCTX) & 1023; const int pos = (wc & 1) ? (t & 63) : (t >> 6);
                    const float* rp = rope + (pos * 16 + 4 * fq) * 2;
                    const f32x4 a = *(const f32x4*)rp, b = *(const f32x4*)(rp + 4);
                    c4 = (f32x4){a.x, a.z, b.x, b.z}; s4 = (f32x4){a.y, a.w, b.y, b.w};
                }
                if (u.pn < 2) {
#pragma unroll
                    for (int bj = 0; bj < 2; ++bj) {
                        const int col = u.pn * 256 + bj * 128 + wc * 32 + 4 * fq;
                        const f32x4 x1 = acc[ai][bj][m][0], x2 = acc[ai][bj][m][1];
                        const f32x4 o1 = (x1 * c4 - x2 * s4) * QSCALE, o2 = (x2 * c4 + x1 * s4) * QSCALE;
                        bf16_t* qp = Q + (size_t)row * 512 + col;
                        *(u32x2*)qp = (u32x2){pg8::cvt_pk_bf16(o1.x, o1.y), pg8::cvt_pk_bf16(o1.z, o1.w)};
                        *(u32x2*)(qp + 16) = (u32x2){pg8::cvt_pk_bf16(o2.x, o2.y), pg8::cvt_pk_bf16(o2.z, o2.w)};
                    }
                } else if (u.pn == 2) {
                    const int kc = wc * 32 + 4 * fq;
                    {
                        const f32x4 x1 = acc[ai][0][m][0], x2 = acc[ai][0][m][1];
                        if (!lat) { float* ok = outk + ((size_t)((row >> 8) * DEPTH + l) * SEQ + (row & 255)) * 128 + kc; __builtin_nontemporal_store(x1, (f32x4*)ok); __builtin_nontemporal_store(x2, (f32x4*)(ok + 16)); }
                        const f32x4 o1 = x1 * c4 - x2 * s4, o2 = x2 * c4 + x1 * s4;
                        bf16_t* kp = Kb + (size_t)row * 128 + kc;
                        *(u32x2*)kp = (u32x2){pg8::cvt_pk_bf16(o1.x, o1.y), pg8::cvt_pk_bf16(o1.z, o1.w)};
                        *(u32x2*)(kp + 16) = (u32x2){pg8::cvt_pk_bf16(o2.x, o2.y), pg8::cvt_pk_bf16(o2.z, o2.w)};
                    }
                    {
                        const f32x4 v1 = acc[ai][1][m][0], v2 = acc[ai][1][m][1];
                        bf16_t* vt; int T;
                        if (!lat) { float* ov = outv + ((size_t)((row >> 8) * DEPTH + l) * SEQ + (row & 255)) * 128 + kc; __builtin_nontemporal_store(v1, (f32x4*)ov); __builtin_nontemporal_store(v2, (f32x4*)(ov + 16));
                            T = SEQ; vt = VT + (size_t)((row >> 8) * 128 + kc) * SEQ + (row & 255); }
                        else { const int r2 = row - MCTX; T = LSEQ; vt = VT + VT_LAT_OFF + (size_t)((r2 >> 10) * 128 + kc) * LSEQ + (r2 & 1023); }
#pragma unroll
                        for (int i = 0; i < 4; ++i) { vt[(size_t)i * T] = (bf16_t)f2bf(v1[i]); vt[(size_t)(16 + i) * T] = (bf16_t)f2bf(v2[i]); }
                    }
                } else {
#pragma unroll
                    for (int bj = 0; bj < 2; ++bj)
#pragma unroll
                        for (int n = 0; n < 2; ++n) {
                            const int pc = (u.pn - 3) * 256 + bj * 128 + wc * 32 + 16 * n + 4 * fq;
                            *(f32x4*)(PP + (size_t)row * 512 + pc) = acc[ai][bj][m][n];
                        }
                }
            }
    }
};

constexpr int ST_WT = 0;
constexpr int XCH_OFF = 131072 + 1024;
template <bool F8IN  , bool H8  >
struct EpiLn {
    static constexpr bool PERM = true, ALIGN = false, LNF = true, FP8 = F8IN;
    float* X; const float* gate; const float* gam; const float* bet; const float* msh; const float* msc; bf16_t* H; float* out; float accs;
    unsigned long long* stats; unsigned* cnt; unsigned* tmo; LAS unsigned char* lds;
    __device__ __forceinline__ void operator()(const f32x4 (&)[2][2][4][2], const pg8::Unit&, int, int, int) const {}
    __device__ __forceinline__ void pre(const f32x4 (&)[2][2][4][2], const pg8::Unit&, int, int, int) const {}
    __device__ __forceinline__ void fused(f32x4 (&y)[2][2][4][2], const pg8::Unit& u, int wr, int wc, int aoff) const {
        PG8_LANE_FROM_AOFF(aoff, fr, fq);
        const int lane_ = fq * 16 + fr, tid = (wr * 4 + wc) * 64 + lane_;
        LAS float* RS = (LAS float*)(lds + XCH_OFF);
        LAS float* RQ = RS + 1024;
        const int cond = u.pm < 16 ? 0 : 1 + ((u.pm - 16) >> 2);
        const int colb = u.pn * 256 + wc * 32 + 8 * fq;
        const unsigned roff = (unsigned)((u.pm * 256 + wr * 64 + fr) * D + colb) * 4u;
        const __amdgpu_buffer_rsrc_t rX = __builtin_amdgcn_make_buffer_rsrc(X, 0, 0x7fffffff, 0x00020000);
        const __amdgpu_buffer_rsrc_t rO = __builtin_amdgcn_make_buffer_rsrc(out ? out : X, 0, 0x7fffffff, 0x00020000);
        const __amdgpu_buffer_rsrc_t rH = __builtin_amdgcn_make_buffer_rsrc(H, 0, 0x7fffffff, 0x00020000);
        f32x4 gv[2][2];
#pragma unroll
        for (int bj = 0; bj < 2; ++bj) { const float* g = gate + (size_t)cond * MODW + colb + bj * 128; gv[bj][0] = *(const f32x4*)g; gv[bj][1] = *(const f32x4*)(g + 4);
            if (F8IN) { gv[bj][0] = gv[bj][0] * accs; gv[bj][1] = gv[bj][1] * accs; } }
#pragma unroll
        for (int ai = 0; ai < 2; ++ai)
#pragma unroll
            for (int m = 0; m < 4; ++m) {
                float sv = 0.f;
#pragma unroll
                for (int bj = 0; bj < 2; ++bj) {
                    const int so = ((ai * 128 + m * 16) * D + bj * 128) * 4;
                    const f32x4 xa = __builtin_bit_cast(f32x4, __builtin_amdgcn_raw_buffer_load_b128(rX, roff, so, 0)), xb = __builtin_bit_cast(f32x4, __builtin_amdgcn_raw_buffer_load_b128(rX, roff + 16u, so, 0));
                    const f32x4 v0 = xa * ALPHA + gv[bj][0] * y[ai][bj][m][0], v1 = xb * ALPHA + gv[bj][1] * y[ai][bj][m][1];
                    y[ai][bj][m][0] = v0; y[ai][bj][m][1] = v1;
                    sv += ((v0.x + v0.y) + (v0.z + v0.w)) + ((v1.x + v1.y) + (v1.z + v1.w));
                }
                sv += shfl_xor_l(sv, lane_, 16); sv += shfl_xor_l(sv, lane_, 32);
                if (fq == 0) RS[wc * 256 + ai * 128 + wr * 64 + m * 16 + fr] = sv;
                if (m == 3) asm volatile("" ::: "memory");
            }
        __syncthreads();
#pragma unroll
        for (int ai = 0; ai < 2; ++ai)
#pragma unroll
            for (int m = 0; m < 4; ++m) {
                const int rl = ai * 128 + wr * 64 + m * 16 + fr;
                const float mu = ((RS[rl] + RS[256 + rl]) + (RS[512 + rl] + RS[768 + rl])) * (1.f / 256.f);
                float q = 0.f;
#pragma unroll
                for (int bj = 0; bj < 2; ++bj)
#pragma unroll
                    for (int n = 0; n < 2; ++n) { const f32x4 v = y[ai][bj][m][n] - mu; q += (v.x * v.x + v.y * v.y) + (v.z * v.z + v.w * v.w); }
                q += shfl_xor_l(q, lane_, 16); q += shfl_xor_l(q, lane_, 32);
                if (fq == 0) RQ[wc * 256 + rl] = q;
            }
        __syncthreads();
        if (tid < 256) {
            const float sm = (RS[tid] + RS[256 + tid]) + (RS[512 + tid] + RS[768 + tid]);
            const float m2 = (RQ[tid] + RQ[256 + tid]) + (RQ[512 + tid] + RQ[768 + tid]);
            const unsigned long long v = (unsigned long long)__builtin_bit_cast(unsigned, sm) | ((unsigned long long)__builtin_bit_cast(unsigned, m2) << 32);
            __hip_atomic_store(stats + ((size_t)(u.pm * 4 + u.pn) * 256 + tid), v, __ATOMIC_RELAXED, __HIP_MEMORY_SCOPE_AGENT);
        }
        asm volatile("s_waitcnt vmcnt(0)" ::: "memory");
        __syncthreads();
        if (tid == 0) {
            (void)xb_add(cnt + u.pm, 1u);
            unsigned sp = 0;
            while (xb_ld(cnt + u.pm) < 4u) { __builtin_amdgcn_s_sleep(0); if (++sp > (1u << 22)) { atomicAdd(tmo, 1u); break; } }
        }
        __syncthreads();
        if (tid < 256) {
            float sj[4], mj[4];
#pragma unroll
            for (int j = 0; j < 4; ++j) { const unsigned long long v = __hip_atomic_load(stats + ((size_t)(u.pm * 4 + j) * 256 + tid), __ATOMIC_RELAXED, __HIP_MEMORY_SCOPE_AGENT);
                sj[j] = __builtin_bit_cast(float, (unsigned)(v & 0xffffffffull)); mj[j] = __builtin_bit_cast(float, (unsigned)(v >> 32)); }
            const float mean = ((sj[0] + sj[1]) + (sj[2] + sj[3])) * (1.f / D);
            float m2 = (mj[0] + mj[1]) + (mj[2] + mj[3]);
#pragma unroll
            for (int j = 0; j < 4; ++j) { const float dm = sj[j] * (1.f / 256.f) - mean; m2 += 256.f * dm * dm; }
            RS[tid] = mean; RQ[tid] = 1.f / sqrtf(m2 * (1.f / D) + LN_EPS);
        }
        __syncthreads();
#pragma unroll
        for (int bj = 0; bj < 2; ++bj) {
            const int col = colb + bj * 128;
            const f32x4 ga0 = *(const f32x4*)(gam + col), ga1 = *(const f32x4*)(gam + col + 4), be0 = *(const f32x4*)(bet + col), be1 = *(const f32x4*)(bet + col + 4);
            f32x4 sc0 = {0.f, 0.f, 0.f, 0.f}, sc1 = sc0, sh0 = sc0, sh1 = sc0;
            if (!out) { const float* ms = msc + (size_t)cond * MODW + col; const float* mh = msh + (size_t)cond * MODW + col;
                sc0 = *(const f32x4*)ms + 1.f; sc1 = *(const f32x4*)(ms + 4) + 1.f; sh0 = *(const f32x4*)mh; sh1 = *(const f32x4*)(mh + 4); }
#pragma unroll
            for (int ai = 0; ai < 2; ++ai) {
#pragma unroll
                for (int m = 0; m < 4; ++m) {
                    const int rl = ai * 128 + wr * 64 + m * 16 + fr;
                    const int so = ((ai * 128 + m * 16) * D + bj * 128) * 4;
                    const float mean = RS[rl], rstd = RQ[rl];
                    const f32x4 x0 = (y[ai][bj][m][0] - mean) * rstd * ga0 + be0, x1 = (y[ai][bj][m][1] - mean) * rstd * ga1 + be1;
                    if (out) { __builtin_amdgcn_raw_buffer_store_b128(__builtin_bit_cast(u32x4, x0), rO, roff, so, 2); __builtin_amdgcn_raw_buffer_store_b128(__builtin_bit_cast(u32x4, x1), rO, roff + 16u, so, 2); }
                    else { __builtin_amdgcn_raw_buffer_store_b128(__builtin_bit_cast(u32x4, x0), rO, roff, so, ST_WT); __builtin_amdgcn_raw_buffer_store_b128(__builtin_bit_cast(u32x4, x1), rO, roff + 16u, so, ST_WT); }
                    if (!out) {
                        const f32x4 h0 = x0 * sc0 + sh0, h1 = x1 * sc1 + sh1;
                        if (H8) { __builtin_amdgcn_raw_buffer_store_b64((u32x2){pk4_fp8(h0.x, h0.y, h0.z, h0.w), pk4_fp8(h1.x, h1.y, h1.z, h1.w)}, rH, roff >> 2, so >> 2, ST_WT); }
                        else { u32x4 w; w.x = pg8::cvt_pk_bf16(h0.x, h0.y); w.y = pg8::cvt_pk_bf16(h0.z, h0.w); w.z = pg8::cvt_pk_bf16(h1.x, h1.y); w.w = pg8::cvt_pk_bf16(h1.z, h1.w);
                            __builtin_amdgcn_raw_buffer_store_b128(w, rH, roff >> 1, so >> 1, ST_WT); } }
                }
                __builtin_amdgcn_sched_barrier(0);
            }
        }
    }
};

#define DPP_F(old, src, ctrl) __builtin_bit_cast(float, __builtin_amdgcn_update_dpp(__builtin_bit_cast(int, (float)(old)), __builtin_bit_cast(int, (float)(src)), (ctrl), 0xF, 0xF, false))
struct EpiUpConv {
    static constexpr bool PERM = true, ALIGN = true, LNF = false, FP8 = UP_FP8;
    unsigned char* ACT; float* HALO; const float* cw; const float* cb; LAS unsigned char* lds;
    __device__ __forceinline__ void pre(const f32x4 (&acc)[2][2][4][2], const pg8::Unit& u, int wr, int wc, int aoff) const {
        PG8_LANE_FROM_AOFF(aoff, fr, fq);
        LAS float* XF = (LAS float*)(lds + XCH_OFF); LAS float* XL = XF + 1024;
        const int colw = wc * 32 + 8 * fq;
        if (fr == 0) {
#pragma unroll
            for (int ai = 0; ai < 2; ++ai)
#pragma unroll
                for (int bj = 0; bj < 2; ++bj)
#pragma unroll
                    for (int n = 0; n < 2; ++n) *(LAS f32x4*)(XF + (2 * ai + wr) * 256 + bj * 128 + colw + 4 * n) = acc[ai][bj][0][n];
        }
        if (fr == 15) {
#pragma unroll
            for (int ai = 0; ai < 2; ++ai)
#pragma unroll
                for (int bj = 0; bj < 2; ++bj)
#pragma unroll
                    for (int n = 0; n < 2; ++n) *(LAS f32x4*)(XL + (2 * ai + wr) * 256 + bj * 128 + colw + 4 * n) = acc[ai][bj][3][n];
        }
        if (u.pm >= 16) {
            float* hb = HALO + (size_t)u.pm * 4 * UPW + u.pn * 256 + colw;
            if (wr == 0 && fr < 2) {
#pragma unroll
                for (int bj = 0; bj < 2; ++bj)
#pragma unroll
                    for (int n = 0; n < 2; ++n) *(f32x4*)(hb + (size_t)fr * UPW + bj * 128 + 4 * n) = acc[0][bj][0][n];
            }
            if (wr == 1 && fr >= 14) {
#pragma unroll
                for (int bj = 0; bj < 2; ++bj)
#pragma unroll
                    for (int n = 0; n < 2; ++n) *(f32x4*)(hb + (size_t)(fr - 12) * UPW + bj * 128 + 4 * n) = acc[1][bj][3][n];
            }
        }
    }
    __device__ __forceinline__ void operator()(const f32x4 (&acc)[2][2][4][2], const pg8::Unit& u, int wr, int wc, int aoff) const {
        PG8_LANE_FROM_AOFF(aoff, fr, fq);
        const LAS float* XF = (const LAS float*)(lds + XCH_OFF); const LAS float* XL = XF + 1024;
        const int colw = wc * 32 + 8 * fq;
        const int ch0 = u.pn * 128 + colw;
#pragma unroll
        for (int n = 0; n < 2; ++n) {
            const int ch = ch0 + 4 * n;
            f32x4 w[2][3], bs[2];
#pragma unroll
            for (int bj = 0; bj < 2; ++bj) {
#pragma unroll
                for (int k = 0; k < 3; ++k) w[bj][k] = *(const f32x4*)(cw + k * UPW + bj * DFF + ch);
                bs[bj] = *(const f32x4*)(cb + bj * DFF + ch);
            }
#pragma unroll
            for (int ai = 0; ai < 2; ++ai) {
                const int blk = 2 * ai + wr;
                f32x4 cv[2][4];
#pragma unroll
                for (int bj = 0; bj < 2; ++bj) {
                    f32x4 bp = {0.f, 0.f, 0.f, 0.f}, bn = {0.f, 0.f, 0.f, 0.f};
                    if (blk > 0) bp = *(const LAS f32x4*)(XL + (blk - 1) * 256 + bj * 128 + colw + 4 * n);
                    if (blk < 3) bn = *(const LAS f32x4*)(XF + (blk + 1) * 256 + bj * 128 + colw + 4 * n);
#pragma unroll
                    for (int m = 0; m < 4; ++m) {
                        const f32x4 v = acc[ai][bj][m][n];
                        f32x4 P, N;
#pragma unroll
                        for (int i = 0; i < 4; ++i) {
                            const float po = m == 0 ? bp[i] : DPP_F(0.f, acc[ai][bj][m == 0 ? 0 : m - 1][n][i], 0x121);
                            const float no = m == 3 ? bn[i] : DPP_F(0.f, acc[ai][bj][m == 3 ? 3 : m + 1][n][i], 0x12F);
                            P[i] = DPP_F(po, v[i], 0x111);
                            N[i] = DPP_F(no, v[i], 0x101);
                        }
                        cv[bj][m] = (w[bj][0] * P + w[bj][1] * v + w[bj][2] * N) * (1.f / S_WUP) + bs[bj];
                    }
                }
#pragma unroll
                for (int m = 0; m < 4; ++m) {
                    const int row = u.pm * 256 + ai * 128 + wr * 64 + m * 16 + fr;
                    const f32x4 a = cv[0][m], g = cv[1][m];
                    f32x4 r;
#pragma unroll
                    for (int i = 0; i < 4; ++i) r[i] = g[i] * __builtin_amdgcn_rcpf(1.f + __expf(-g[i])) * a[i] * S_ACT;
                    if (u.pm >= 16 && ((ai == 0 && m == 0 && wr == 0 && fr == 0 && ((u.pm - 16) & 3) != 0) || (ai == 1 && m == 3 && wr == 1 && fr == 15 && ((u.pm - 16) & 3) != 3))) continue;
                    if (DOWN_FP8) *(unsigned*)(ACT + (size_t)row * DFF + ch) = pk4_fp8(r.x, r.y, r.z, r.w);
                    else *(u32x2*)(ACT + ((size_t)row * DFF + ch) * 2) = (u32x2){pg8::cvt_pk_bf16(r.x, r.y), pg8::cvt_pk_bf16(r.z, r.w)};
                }
            }
        }
    }
};

template <int MODE>
__device__ __forceinline__ void transpose_item(const float* W, int npitch, int nblk, bf16_t* WT, int ldk, LAS float* scr, int item, int lane) {
    const int kb = item / nblk, nb = item % nblk, k0 = 64 * kb, n0 = 32 * nb;
    float tv[32];
#pragma unroll
    for (int i = 0; i < 32; ++i) tv[i] = __builtin_nontemporal_load(&W[(size_t)(k0 + 2 * i + (lane >> 5)) * npitch + n0 + (lane & 31)]);
#pragma unroll
    for (int i = 0; i < 32; ++i) scr[(2 * i + (lane >> 5)) * 33 + (lane & 31)] = tv[i];
    LDS_WAIT();
    const int c = lane & 7;
#pragma unroll
    for (int j = 0; j < 4; ++j) { const int n = (lane >> 3) + 8 * j; const LAS float* s = scr + (8 * c) * 33 + n;
        const int nn = n0 + n;
        int drow = nn;
        if (MODE == 1 || MODE == 2) { drow = nn < DFF ? (nn >> 7) * 256 + (nn & 127) : ((nn - DFF) >> 7) * 256 + 128 + ((nn - DFF) & 127); }
        if (MODE >= 2) {
            const float sc_ = MODE == 2 ? S_WUP : (MODE == 3 ? S_WDN : S_WOUT);
            *(u32x2*)((unsigned char*)WT + (size_t)drow * ldk + k0 + 8 * c) = (u32x2){pk4_fp8(s[0 * 33] * sc_, s[1 * 33] * sc_, s[2 * 33] * sc_, s[3 * 33] * sc_), pk4_fp8(s[4 * 33] * sc_, s[5 * 33] * sc_, s[6 * 33] * sc_, s[7 * 33] * sc_)};
        } else {
            u32x4 o; o.x = pk2(s[0 * 33], s[1 * 33]); o.y = pk2(s[2 * 33], s[3 * 33]); o.z = pk2(s[4 * 33], s[5 * 33]); o.w = pk2(s[6 * 33], s[7 * 33]);
            *(u32x4*)(WT + (size_t)drow * ldk + k0 + 8 * c) = o; } }
    LDS_WAIT();
}

enum { PREP_MODS = 1, PREP_FOLD = 2, PREP_W0 = 4, PREP_W1 = 8, PREP_MISC = 16 };
__device__ __forceinline__ void prep_items(const Params& p, LAS unsigned char* lds, int wv, int L, int what, int bj, int nb) {
    int tid_ = TID(wv); asm volatile("" : "+v"(tid_));
    const int tid = tid_, lane = tid & 63, wave = wv;
    unsigned char* ws = p.ws;
    float* mods = (float*)(ws + WS_MODS);
    if ((what & PREP_MISC) && bj == 0) {
        float* rope = (float*)(ws + WS_ROPE);
        for (int idx = tid; idx < 1024; idx += 512) {
            const int pos = idx >> 4, i = idx & 15;
            const float inv = exp2f(-(float)i * (13.287712379549449f / 16.f));
            float ang = (float)pos * inv;
            const float k = rintf(ang * 0.15915494309189535f);
            ang = fmaf(-k, 6.28318548202514648f, ang); ang = fmaf(-k, -1.74845553e-07f, ang);
            rope[idx * 2] = __cosf(ang); rope[idx * 2 + 1] = __sinf(ang);
        }
    }
    const int b_lo = (what & PREP_MODS) ? 0 : 96, b_hi = (what & PREP_FOLD) ? 224 : 96;
    for (int it = b_lo + bj; it < b_hi; it += nb) {
        const int l = L;
        if (it < 96) {
            LAS float* sc = (LAS float*)lds;
            LAS float* part = (LAS float*)(lds + 36864);
            __syncthreads();
            for (int idx = tid; idx < NCOND * D; idx += 512) { const int c = idx >> 10, k = idx & 1023;
                const float v = c == 0 ? p.in[I_CCTX][k] : p.in[I_C][(c - 1) * D + k]; sc[idx] = v / (1.f + __expf(-v)); }
            __syncthreads();
            const int n0 = it * 64;
            float a0[NCOND];
#pragma unroll
            for (int c = 0; c < NCOND; ++c) a0[c] = 0.f;
            const float* wp = p.in[I_WMOD] + ((size_t)l * D + wave * 128) * MODW + n0 + lane;
            for (int k = 0; k < 128; k += 16) {
                float w[16];
#pragma unroll
                for (int j = 0; j < 16; ++j) w[j] = __builtin_nontemporal_load(&wp[(size_t)(k + j) * MODW]);
#pragma unroll
                for (int q = 0; q < 4; ++q)
#pragma unroll
                    for (int c = 0; c < NCOND; ++c) { const f32x4 s = *(const LAS f32x4*)(sc + c * D + wave * 128 + k + 4 * q);
                        a0[c] += s.x * w[4 * q] + s.y * w[4 * q + 1] + s.z * w[4 * q + 2] + s.w * w[4 * q + 3]; }
            }
#pragma unroll
            for (int c = 0; c < NCOND; ++c) part[(wave * NCOND + c) * 64 + lane] = a0[c];
            __syncthreads();
            for (int idx = tid; idx < NCOND * 64; idx += 512) { const int c = idx >> 6, j = idx & 63; float s = p.in[I_BMOD][l * MODW + n0 + j];
#pragma unroll
                for (int w = 0; w < 8; ++w) s += part[(w * NCOND + c) * 64 + j];
                mods[(size_t)(l * NCOND + c) * MODW + n0 + j] = s; }
            __syncthreads();
        } else {
            const int f = it - 96, g = (f >> 5) & 3, k0 = (f & 31) * 32;
            LAS float* Wp = (LAS float*)lds;
            LAS float* As = (LAS float*)(lds + 65536);
            __syncthreads();
            const float* wpool = p.in[I_WPOOL] + (size_t)(l * 4 + g) * 16384;
#pragma unroll
            for (int j = 0; j < 8; ++j) *(LAS f32x4*)(Wp + (tid + 512 * j) * 4) = *(const f32x4*)(wpool + (tid + 512 * j) * 4);
#pragma unroll
            for (int j = 0; j < 2; ++j) { const int e = tid + 512 * j, kk = e >> 5, c4 = (e & 31) * 4;
                *(LAS f32x4*)(As + kk * 132 + c4) = *(const f32x4*)(p.in[I_WIN] + ((size_t)l * D + k0 + kk) * INW + 768 + g * 128 + c4); }
            __syncthreads();
            const int j = tid & 127, kq = tid >> 7;
            float acc[8];
#pragma unroll
            for (int i = 0; i < 8; ++i) acc[i] = 0.f;
            for (int c = 0; c < 128; c += 4) {
                const float w0 = Wp[(c + 0) * 128 + j], w1 = Wp[(c + 1) * 128 + j], w2 = Wp[(c + 2) * 128 + j], w3 = Wp[(c + 3) * 128 + j];
#pragma unroll
                for (int i = 0; i < 8; ++i) { const f32x4 a = *(const LAS f32x4*)(As + (kq * 8 + i) * 132 + c); acc[i] += a.x * w0 + a.y * w1 + a.z * w2 + a.w * w3; }
            }
            const float ps = p.in[I_PSCALE][l * 512 + g * 128 + j];
            u32x4 o; o.x = pk2(acc[0] * ps, acc[1] * ps); o.y = pk2(acc[2] * ps, acc[3] * ps); o.z = pk2(acc[4] * ps, acc[5] * ps); o.w = pk2(acc[6] * ps, acc[7] * ps);
            *(u32x4*)((bf16_t*)(ws + WS_WIN) + ((size_t)l * INW + 768 + g * 128 + j) * D + k0 + kq * 8) = o;
            __syncthreads();
        }
    }
    __syncthreads();
    LAS float* scr = (LAS float*)(lds + wave * 16384);
    const int gw = bj * 8 + wave, NGW = nb * 8;
    constexpr int I_IN = 16 * 24, I_OUT = 16 * 32, I_UP = 16 * 176, I_DN = 44 * 32, PER_L = I_IN + I_OUT + I_UP + I_DN;
    constexpr int N_CV = 32 * 16, N_CK = 2048;
    const int w_lo = (what & PREP_W0) ? 0 : ((what & PREP_W1) ? PER_L / 2 : PER_L), w_hi = (what & PREP_MISC) ? PER_L + N_CV + N_CK : ((what & PREP_W1) ? PER_L : ((what & PREP_W0) ? PER_L / 2 : 0));
    for (int it = w_lo + gw; it < w_hi; it += NGW) {
        if (it < PER_L) {
            if (!(what & PREP_W1) && it >= PER_L / 2) continue;
            const int l = L; int r = it;
            if (r < I_IN) { transpose_item<0>(p.in[I_WIN] + (size_t)l * D * INW, INW, 24, (bf16_t*)(ws + WS_WIN) + (size_t)l * INW * D, D, scr, r, lane); continue; } r -= I_IN;
            if (r < I_OUT) { if (OUT_FP8) transpose_item<4>(p.in[I_WOUT] + (size_t)l * D * D, D, 32, (bf16_t*)(ws + WS_WOUT + (size_t)l * D * D), D, scr, r, lane);
                             else transpose_item<0>(p.in[I_WOUT] + (size_t)l * D * D, D, 32, (bf16_t*)(ws + WS_WOUT) + (size_t)l * D * D, D, scr, r, lane); continue; } r -= I_OUT;
            if (r < I_UP) { if (UP_FP8) transpose_item<2>(p.in[I_WUP] + (size_t)l * D * UPW, UPW, 176, (bf16_t*)(ws + WS_WUP + (size_t)l * UPW * D), D, scr, r, lane);
                            else transpose_item<1>(p.in[I_WUP] + (size_t)l * D * UPW, UPW, 176, (bf16_t*)(ws + WS_WUP) + (size_t)l * UPW * D, D, scr, r, lane); continue; } r -= I_UP;
            if (DOWN_FP8) transpose_item<3>(p.in[I_WDOWN] + (size_t)l * DFF * D, D, 32, (bf16_t*)(ws + WS_WDN + (size_t)l * D * DFF), DFF, scr, r, lane);
            else transpose_item<0>(p.in[I_WDOWN] + (size_t)l * DFF * D, D, 32, (bf16_t*)(ws + WS_WDN) + (size_t)l * D * DFF, DFF, scr, r, lane);
        } else if (it < PER_L + N_CV) {
            const int f = it - PER_L, bl = f >> 4, b = bl >> 2, l = bl & 3;
            transpose_item<0>(p.in[I_CV] + (size_t)(b * DEPTH + l) * PAST * 128, 128, 4, (bf16_t*)(ws + WS_VCT) + (size_t)(l * NLAT + b) * 128 * PAST, PAST, scr, f & 15, lane);
        } else {
            const int f = it - PER_L - N_CV; const int e0 = f * 512 + lane * 8, lb = e0 >> 15, rem = e0 & 32767, l = lb >> 3, b = lb & 7;
            const float* s = p.in[I_CK] + (size_t)(b * DEPTH + l) * 32768 + rem;
            const f32x4 v0 = __builtin_nontemporal_load((const f32x4*)s), v1 = __builtin_nontemporal_load((const f32x4*)(s + 4));
            u32x4 o; o.x = pk2(v0.x, v0.y); o.y = pk2(v0.z, v0.w); o.z = pk2(v1.x, v1.y); o.w = pk2(v1.z, v1.w);
            *(u32x4*)((bf16_t*)(ws + WS_KC) + e0) = o;
        }
    }
    __syncthreads();
}

__device__ __forceinline__ void prologue_b(const Params& p, int wv) {
    const int lane = lane_id(), gw = blockIdx.x * 8 + wv, NGW = gridDim.x * 8;
    const float* mods = (const float*)(p.ws + WS_MODS);
    float* X = (float*)(p.ws + WS_X); bf16_t* H = (bf16_t*)(p.ws + WS_H);
    for (int row = gw; row < MTOT; row += NGW) {
        const float* src = row < MCTX ? p.in[I_XP] + (size_t)row * D : p.in[I_XS] + (size_t)(row - MCTX) * D;
        const float* md = mods + (size_t)cond_of_row(row) * MODW;
#pragma unroll
        for (int j = 0; j < 4; ++j) { const int col = 4 * lane + 256 * j;
            const f32x4 v = __builtin_nontemporal_load((const f32x4*)(src + col)), sh = *(const f32x4*)(md + col), sc = *(const f32x4*)(md + D + col);
            *(f32x4*)(X + (size_t)row * D + col) = v;
            const f32x4 h = v * (sc + 1.f) + sh;
            *(u32x2*)(H + (size_t)row * D + col) = (u32x2){pk2(h.x, h.y), pk2(h.z, h.w)}; }
    }
}

__device__ __forceinline__ void convfix_pass(const Params& p, int l, int wv) {
    const float* HALO = (const float*)(p.ws + WS_HALO); unsigned char* ACT = p.ws + WS_ACT;
    const float* cw = p.in[I_CONVW] + (size_t)l * 3 * UPW; const float* cb = p.in[I_CONVB] + (size_t)l * UPW;
    int tid_ = TID(wv); asm volatile("" : "+v"(tid_));
    const int gt = blockIdx.x * 512 + tid_, NT = gridDim.x * 512;
    constexpr int NQ = DFF / 4, NITEM = 24 * 2 * NQ;
    for (int it = gt; it < NITEM; it += NT) {
        const int q = it % NQ, wh = (it / NQ) & 1, bd = it / (2 * NQ);
        const int ch = q * 4, ucol = (ch >> 7) * 256 + (ch & 127);
        const int pm_lo = 16 + (bd / 3) * 4 + (bd % 3), pm_hi = pm_lo + 1;
        const float* h0; const float* h1; const float* h2; int row;
        if (wh == 0) { h0 = HALO + ((size_t)pm_lo * 4 + 2) * UPW; h1 = HALO + ((size_t)pm_lo * 4 + 3) * UPW; h2 = HALO + ((size_t)pm_hi * 4 + 0) * UPW; row = pm_lo * 256 + 255; }
        else         { h0 = HALO + ((size_t)pm_lo * 4 + 3) * UPW; h1 = HALO + ((size_t)pm_hi * 4 + 0) * UPW; h2 = HALO + ((size_t)pm_hi * 4 + 1) * UPW; row = pm_hi * 256; }
        f32x4 cv[2];
#pragma unroll
        for (int bj = 0; bj < 2; ++bj) {
            const int uc = ucol + bj * 128, wc_ = bj * DFF + ch;
            cv[bj] = (*(const f32x4*)(cw + wc_) * *(const f32x4*)(h0 + uc) + *(const f32x4*)(cw + UPW + wc_) * *(const f32x4*)(h1 + uc)
                   + *(const f32x4*)(cw + 2 * UPW + wc_) * *(const f32x4*)(h2 + uc)) * (1.f / S_WUP) + *(const f32x4*)(cb + wc_);
        }
        f32x4 r;
#pragma unroll
        for (int i = 0; i < 4; ++i) r[i] = cv[1][i] * __builtin_amdgcn_rcpf(1.f + __expf(-cv[1][i])) * cv[0][i] * S_ACT;
        if (DOWN_FP8) *(unsigned*)(ACT + (size_t)row * DFF + ch) = pk4_fp8(r.x, r.y, r.z, r.w);
        else *(u32x2*)(ACT + ((size_t)row * DFF + ch) * 2) = (u32x2){pg8::cvt_pk_bf16(r.x, r.y), pg8::cvt_pk_bf16(r.z, r.w)};
    }
}

constexpr int KPITCH = 72;
__device__ __forceinline__ void attn_unit(const Params& p, LAS unsigned char* lds, int l, int unit, int wv) {
    int tid_ = TID(wv); asm volatile("" : "+v"(tid_));
    const int tid = tid_, lane = tid & 63, w = tid >> 6, qi = lane & 31, hi = lane >> 5;
    const bool lat = unit < 256;
    int b, kvh, qb, T, seqrow0;
    if (lat) { b = unit >> 5; kvh = (unit >> 4) & 1; qb = unit & 15; T = LSEQ; seqrow0 = MCTX + b * LSEQ; }
    else { const int u = unit - 256; b = u >> 3; kvh = (u >> 2) & 1; qb = u & 3; T = SEQ; seqrow0 = b * SEQ; }
    const int jlo = lat ? (qb - 2 < 0 ? 0 : qb - 2) : 0, jhi = lat ? (qb + 2 > 15 ? 15 : qb + 2) : 3;
    const int nt = lat ? 4 + (jhi - jlo + 1) : 4;
    const bf16_t* Q = (const bf16_t*)(p.ws + WS_Q); const bf16_t* Kb = (const bf16_t*)(p.ws + WS_K); const bf16_t* VT = (const bf16_t*)(p.ws + WS_VT);
    const bf16_t* Kc = (const bf16_t*)(p.ws + WS_KC); const bf16_t* Vct = (const bf16_t*)(p.ws + WS_VCT);
    bf16_t* MIX = (bf16_t*)(p.ws + WS_MIX);
    const int g = w & 3, qh = w >> 2, head = kvh * 4 + g;
    const int qrow = seqrow0 + qb * 64 + qh * 32 + qi;
    const int qpos = qb * 64 + qh * 32 + qi;
    bf16x8 qf[4];
#pragma unroll
    for (int ks = 0; ks < 4; ++ks) qf[ks] = *(const bf16x8*)(Q + (size_t)qrow * 512 + head * 64 + ks * 16 + hi * 8);
    const float sink2 = p.in[I_SINK][l * 8 + head] * LOG2E;
    float mrun = sink2, lrun = 0.f;
    f32x16 o0, o1;
#pragma unroll
    for (int i = 0; i < 16; ++i) { o0[i] = 0.f; o1[i] = 0.f; }
    const bf16_t* vseq = lat ? VT + VT_LAT_OFF + (size_t)(b * 128 + kvh * 64) * LSEQ : VT + (size_t)(b * 128 + kvh * 64) * SEQ;
    const int sr = tid >> 3, sc8 = (tid & 7) * 8;
    u32x4 kreg, vreg;
#define ATT_LOAD(t) do { \
        if (lat && (t) < 4) { kreg = *(const u32x4*)(Kc + ((size_t)(l * NLAT + b) * PAST + (t) * 64 + sr) * 128 + kvh * 64 + sc8); \
                              vreg = *(const u32x4*)(Vct + ((size_t)((l * NLAT + b) * 2 + kvh) * 64 + sr) * PAST + (t) * 64 + sc8); } \
        else { const int jt_ = lat ? jlo + (t) - 4 : (t); \
               kreg = *(const u32x4*)(Kb + ((size_t)seqrow0 + jt_ * 64 + sr) * 128 + kvh * 64 + sc8); \
               vreg = *(const u32x4*)(vseq + (size_t)sr * T + jt_ * 64 + sc8); } } while (0)
#define ATT_STORE(buf) do { *(LAS u32x4*)(lds + ((buf) * 64 + sr) * (KPITCH * 2) + sc8 * 2) = kreg; \
                            *(LAS u32x4*)(lds + 18432 + ((buf) * 64 + sr) * (KPITCH * 2) + sc8 * 2) = vreg; } while (0)
    __syncthreads();
    ATT_LOAD(0); ATT_STORE(0);
    __syncthreads();
    for (int t = 0; t < nt; ++t) {
        const int buf = t & 1;
        if (t + 1 < nt) ATT_LOAD(t + 1);
        const LAS unsigned char* ks = lds + (buf * 64) * (KPITCH * 2);
        const LAS unsigned char* vs = lds + 18432 + (buf * 64) * (KPITCH * 2);
        f32x16 s0, s1;
#pragma unroll
        for (int i = 0; i < 16; ++i) { s0[i] = 0.f; s1[i] = 0.f; }
#pragma unroll
        for (int kk = 0; kk < 4; ++kk) {
            const bf16x8 a0 = *(const LAS bf16x8*)(ks + qi * (KPITCH * 2) + (kk * 16 + hi * 8) * 2);
            const bf16x8 a1 = *(const LAS bf16x8*)(ks + (32 + qi) * (KPITCH * 2) + (kk * 16 + hi * 8) * 2);
            s0 = __builtin_amdgcn_mfma_f32_32x32x16_bf16(a0, qf[kk], s0, 0, 0, 0);
            s1 = __builtin_amdgcn_mfma_f32_32x32x16_bf16(a1, qf[kk], s1, 0, 0, 0);
        }
        if (lat && t >= 4 && (jlo + t - 4 - qb == 2 || qb - (jlo + t - 4) == 2)) {
            const int kbase = (jlo + t - 4) * 64 + 4 * hi;
#pragma unroll
            for (int i = 0; i < 16; ++i) { const int kp = kbase + (i & 3) + 8 * (i >> 2); int d0 = qpos - kp; d0 = d0 < 0 ? -d0 : d0; int d1 = qpos - (kp + 32); d1 = d1 < 0 ? -d1 : d1;
                if (d0 > 128) s0[i] = -1e30f; if (d1 > 128) s1[i] = -1e30f; }
        }
        float mx = s0[0];
#pragma unroll
        for (int i = 1; i < 16; ++i) mx = fmaxf(mx, s0[i]);
#pragma unroll
        for (int i = 0; i < 16; ++i) mx = fmaxf(mx, s1[i]);
        mx = fmaxf(mx, shfl_xor_l(mx, lane, 32));
        const float mnew = fmaxf(mrun, mx), alpha = __builtin_amdgcn_exp2f(mrun - mnew);
        mrun = mnew;
        float ps = 0.f;
#pragma unroll
        for (int i = 0; i < 16; ++i) { s0[i] = __builtin_amdgcn_exp2f(s0[i] - mnew); s1[i] = __builtin_amdgcn_exp2f(s1[i] - mnew); ps += s0[i] + s1[i]; }
        lrun = lrun * alpha + ps;
#pragma unroll
        for (int i = 0; i < 16; ++i) { o0[i] *= alpha; o1[i] *= alpha; }
#pragma unroll
        for (int kb = 0; kb < 2; ++kb)
#pragma unroll
            for (int st = 0; st < 2; ++st) {
                bf16x8 pb;
                {
                    const f32x16& sx = kb == 0 ? s0 : s1;
                    const unsigned w0 = pg8::cvt_pk_bf16(sx[8 * st + 0], sx[8 * st + 1]), w1 = pg8::cvt_pk_bf16(sx[8 * st + 2], sx[8 * st + 3]);
                    const unsigned w2 = pg8::cvt_pk_bf16(sx[8 * st + 4], sx[8 * st + 5]), w3 = pg8::cvt_pk_bf16(sx[8 * st + 6], sx[8 * st + 7]);
                    pb = __builtin_bit_cast(bf16x8, (u32x4){w0, w1, w2, w3});
                }
                const int kcol = kb * 32 + 16 * st + 4 * hi;
                const u32x2 va0 = *(const LAS u32x2*)(vs + qi * (KPITCH * 2) + kcol * 2), va1 = *(const LAS u32x2*)(vs + qi * (KPITCH * 2) + (kcol + 8) * 2);
                const u32x2 vb0 = *(const LAS u32x2*)(vs + (32 + qi) * (KPITCH * 2) + kcol * 2), vb1 = *(const LAS u32x2*)(vs + (32 + qi) * (KPITCH * 2) + (kcol + 8) * 2);
                const bf16x8 va = __builtin_bit_cast(bf16x8, (u32x4){va0.x, va0.y, va1.x, va1.y});
                const bf16x8 vb = __builtin_bit_cast(bf16x8, (u32x4){vb0.x, vb0.y, vb1.x, vb1.y});
                o0 = __builtin_amdgcn_mfma_f32_32x32x16_bf16(va, pb, o0, 0, 0, 0);
                o1 = __builtin_amdgcn_mfma_f32_32x32x16_bf16(vb, pb, o1, 0, 0, 0);
            }
        if (t + 1 < nt) ATT_STORE(buf ^ 1);
        __syncthreads();
    }
#undef ATT_LOAD
#undef ATT_STORE
    const float ltot = lrun + shfl_xor_l(lrun, lane, 32) + __builtin_amdgcn_exp2f(sink2 - mrun);
    const float inv = 1.f / ltot;
    if (OUT_FP8) {
        unsigned char* op = (unsigned char*)MIX + (size_t)qrow * D + head * 64 + 4 * hi; const float is = inv * S_MIX;
#pragma unroll
        for (int gq = 0; gq < 4; ++gq) {
            *(unsigned*)(op + 8 * gq) = pk4_fp8(o0[4 * gq] * is, o0[4 * gq + 1] * is, o0[4 * gq + 2] * is, o0[4 * gq + 3] * is);
            *(unsigned*)(op + 32 + 8 * gq) = pk4_fp8(o1[4 * gq] * is, o1[4 * gq + 1] * is, o1[4 * gq + 2] * is, o1[4 * gq + 3] * is);
        }
    } else {
    bf16_t* op = MIX + (size_t)qrow * D + head * 64 + 4 * hi;
#pragma unroll
    for (int gq = 0; gq < 4; ++gq) {
        *(u32x2*)(op + 8 * gq) = (u32x2){pg8::cvt_pk_bf16(o0[4 * gq] * inv, o0[4 * gq + 1] * inv), pg8::cvt_pk_bf16(o0[4 * gq + 2] * inv, o0[4 * gq + 3] * inv)};
        *(u32x2*)(op + 32 + 8 * gq) = (u32x2){pg8::cvt_pk_bf16(o1[4 * gq] * inv, o1[4 * gq + 1] * inv), pg8::cvt_pk_bf16(o1[4 * gq + 2] * inv, o1[4 * gq + 3] * inv)};
    }
    }
}

__device__ __forceinline__ void pool_unit(const Params& p, int unit, int wv) {
    const float* PP = (const float*)(p.ws + WS_PP); bf16_t* MIX = (bf16_t*)(p.ws + WS_MIX);
    int tid_ = TID(wv); asm volatile("" : "+v"(tid_));
    const int cq = tid_ & 127, rs = tid_ >> 7, grp = cq >> 5, win = 2 << grp, half = win >> 1;
    const int row0 = unit * 64 + rs * 16;
    const int T = row0 < MCTX ? SEQ : LSEQ, t0 = row0 < MCTX ? (row0 & 255) : ((row0 - MCTX) & 1023), seq0 = row0 - t0;
    const float* base = PP + (size_t)seq0 * 512 + cq * 4;
    f32x4 sum = {0.f, 0.f, 0.f, 0.f};
#pragma unroll
    for (int k = 0; k < 16; ++k) { const int j = t0 - half + k; if (k < win && j >= 0 && j < T) sum += *(const f32x4*)(base + (size_t)j * 512); }
    f32x4 own[16], ent[16], lea[16];
#pragma unroll
    for (int i = 0; i < 16; ++i) { const int t = t0 + i; own[i] = *(const f32x4*)(base + (size_t)t * 512);
        ent[i] = (f32x4){0.f, 0.f, 0.f, 0.f}; lea[i] = (f32x4){0.f, 0.f, 0.f, 0.f};
        if (t + half < T) ent[i] = *(const f32x4*)(base + (size_t)(t + half) * 512);
        if (t - half >= 0) lea[i] = *(const f32x4*)(base + (size_t)(t - half) * 512); }
#pragma unroll
    for (int i = 0; i < 16; ++i) { const int t = t0 + i;
        const int s = t - half < 0 ? 0 : t - half, e = t + half > T ? T : t + half;
        const f32x4 d = sum * (1.f / (float)(e - s)) - own[i];
        if (OUT_FP8) *(unsigned*)((unsigned char*)MIX + (size_t)(seq0 + t) * D + 512 + cq * 4) = pk4_fp8(d.x * S_MIX, d.y * S_MIX, d.z * S_MIX, d.w * S_MIX);
        else *(u32x2*)(MIX + (size_t)(seq0 + t) * D + 512 + cq * 4) = (u32x2){pk2(d.x, d.y), pk2(d.z, d.w)};
        sum = sum + ent[i] - lea[i]; }
}

__global__ void __launch_bounds__(512, 2) mega_fwd(Params p) {
    extern __shared__ __attribute__((aligned(16))) unsigned char lds_raw[];
    LAS unsigned char* lds = (LAS unsigned char*)lds_raw;
    unsigned char* ws = p.ws;
    const int G = gridDim.x;
    float* mods = (float*)(ws + WS_MODS);

#ifndef REP_SYNC
#define REP_SYNC 0
#endif
#ifndef REP_KIND
#define REP_KIND -2
#endif
    volatile LAS unsigned* xst = (volatile LAS unsigned*)(lds + 131072 + 64);
    unsigned* xbar = (unsigned*)(ws + WS_BAR);
    const int wv = __builtin_amdgcn_readfirstlane((int)threadIdx.x >> 6);
    if (wv == 0 && lane_id() == 0) { xst[0] = 0u; xst[1] = 0u; }
    __syncthreads();
    xcd_barrier_post(xbar, wv);
    prep_items(p, lds, wv, 0, PREP_MODS | PREP_FOLD | PREP_W0 | PREP_W1 | PREP_MISC, (int)blockIdx.x, G);
    xcd_barrier(xbar, xst, wv);

#pragma unroll 1
    for (int ph = -1; ph < 6 * DEPTH; ++ph) {
        const int l = ph < 0 ? 0 : ph / 6, kind = ph < 0 ? -1 : ph % 6;
#pragma unroll 1
        for (int rep = (kind == REP_KIND ? 1 : 0); rep >= 0; --rep) {
        if (kind == -1) prologue_b(p, wv);
        else if (kind == 0) {
            pg8::Gemm g{(const bf16_t*)(ws + WS_H), (const bf16_t*)(ws + WS_WIN) + (size_t)l * INW * D, MTOT, INW, D};
            pg8::StaticOrder S; S.init(MTOT, INW, G, (int)blockIdx.x);
            EpiIn E{l, (bf16_t*)(ws + WS_Q), (bf16_t*)(ws + WS_K), (bf16_t*)(ws + WS_VT), (float*)(ws + WS_PP), (const float*)(ws + WS_ROPE),
                    p.out + (size_t)MTOT * D, p.out + (size_t)MTOT * D + (size_t)NCTX * DEPTH * SEQ * 128};
            pg8::gemm_phase<EpiIn, pg8::StaticOrder>(lds, g, S, E, wv);
        } else if (kind == 1) {
            for (int r = 0; r < 3; ++r) { const int u = r * G + (r == 2 ? (int)((blockIdx.x + G / 2) % G) : (int)blockIdx.x);
                if (u < 576) { if (u < 384) attn_unit(p, lds, l, u, wv); else pool_unit(p, u - 384, wv); } }
        } else if (kind == 2) {
            pg8::Gemm g{(const bf16_t*)(ws + WS_MIX), (const bf16_t*)(ws + WS_WOUT + (size_t)l * D * D * (OUT_FP8 ? 1 : 2)), MTOT, D, OUT_FP8 ? D / 2 : D};
            pg8::StaticOrder S; S.init(MTOT, D, G, (int)blockIdx.x);
            const float* ml = mods + (size_t)l * NCOND * MODW;
            EpiLn<OUT_FP8, UP_FP8> E{(float*)(ws + WS_X), ml + 2 * D, p.in[I_LN1G] + l * D, p.in[I_LN1B] + l * D, ml + 3 * D, ml + 4 * D, (bf16_t*)(ws + (UP_FP8 ? WS_H8 : WS_H)), nullptr, 1.f / (S_WOUT * S_MIX),
                    (unsigned long long*)(ws + WS_STATS), xbar + XCD_BAR_WORDS + (l * 2 + 0) * 64, xbar + XB_TMO, lds};
            pg8::gemm_phase<EpiLn<OUT_FP8, UP_FP8>, pg8::StaticOrder>(lds, g, S, E, wv);
            if (l + 1 < DEPTH) {
                if (G > 192) { if ((int)blockIdx.x >= 192) prep_items(p, lds, wv, l + 1, PREP_W0, (int)blockIdx.x - 192, G - 192); }
                else prep_items(p, lds, wv, l + 1, PREP_W0, (int)blockIdx.x, G);
            }
        } else if (kind == 3) {
            pg8::Gemm g{(const bf16_t*)(ws + (UP_FP8 ? WS_H8 : WS_H)), (const bf16_t*)(ws + WS_WUP + (size_t)l * UPW * D * (UP_FP8 ? 1 : 2)), MTOT, UPW, UP_FP8 ? D / 2 : D};
            pg8::StaticOrder S; S.init(MTOT, UPW, G, (int)blockIdx.x);
            EpiUpConv E{ws + WS_ACT, (float*)(ws + WS_HALO), p.in[I_CONVW] + (size_t)l * 3 * UPW, p.in[I_CONVB] + (size_t)l * UPW, lds};
            pg8::gemm_phase<EpiUpConv, pg8::StaticOrder>(lds, g, S, E, wv);
            if (l + 1 < DEPTH) prep_items(p, lds, wv, l + 1, PREP_MODS | PREP_FOLD, ((int)blockIdx.x + G - 32) % G, G);
        } else if (kind == 4) convfix_pass(p, l, wv);
        else {
            pg8::Gemm g{(const bf16_t*)(ws + WS_ACT), (const bf16_t*)(ws + WS_WDN + (size_t)l * D * DFF * (DOWN_FP8 ? 1 : 2)), MTOT, D, DOWN_FP8 ? DFF / 2 : DFF};
            pg8::StaticOrder S; S.init(MTOT, D, G, (int)blockIdx.x);
            const float* ml = mods + (size_t)l * NCOND * MODW; const float* mn = mods + (size_t)(l + 1 < DEPTH ? l + 1 : l) * NCOND * MODW;
            EpiLn<DOWN_FP8, false> E{(float*)(ws + WS_X), ml + 5 * D, p.in[I_LN2G] + l * D, p.in[I_LN2B] + l * D, mn, mn + D, (bf16_t*)(ws + WS_H), l + 1 < DEPTH ? nullptr : p.out, 1.f / (S_WDN * S_ACT),
                    (unsigned long long*)(ws + WS_STATS), xbar + XCD_BAR_WORDS + (l * 2 + 1) * 64, xbar + XB_TMO, lds};
            pg8::gemm_phase<EpiLn<DOWN_FP8, false>, pg8::StaticOrder>(lds, g, S, E, wv);
            if (l + 1 < DEPTH) {
                if (G > 192) { if ((int)blockIdx.x >= 192) prep_items(p, lds, wv, l + 1, PREP_W1, (int)blockIdx.x - 192, G - 192); }
                else prep_items(p, lds, wv, l + 1, PREP_W1, (int)blockIdx.x, G);
            }
        }
        if (rep > 0) __syncthreads();
        }
        if (ph + 1 < 6 * DEPTH) { xcd_barrier(xbar, xst, wv); if (REP_SYNC) xcd_barrier(xbar, xst, wv); }
    }
}

extern "C" void kernel_launch(void* const* d_in, const int* in_sizes, int n_in, void* d_out, int out_size, void* d_ws, size_t ws_size, hipStream_t stream) {
    static int grid_blocks = 0;
    if (grid_blocks == 0) {
        if (n_in != 21 || ws_size < WS_END) { fprintf(stderr, "kernel_launch: unexpected n_in %d / ws_size %zu (need %zu)\n", n_in, ws_size, (size_t)WS_END); grid_blocks = -1; return; }
        int dev = 0, cus = 0, per_cu = 0;
        hipGetDevice(&dev);
        hipDeviceGetAttribute(&cus, hipDeviceAttributeMultiprocessorCount, dev);
        hipFuncSetAttribute((const void*)mega_fwd, hipFuncAttributeMaxDynamicSharedMemorySize, LDS_BYTES);
        hipOccupancyMaxActiveBlocksPerMultiprocessor(&per_cu, (const void*)mega_fwd, 512, LDS_BYTES);
        if (per_cu < 1) { fprintf(stderr, "kernel_launch: occupancy query reports %d blocks per CU\n", per_cu); per_cu = 1; }
        if (per_cu > 1) per_cu = 1;
        grid_blocks = cus * per_cu;
        (void)hipGetLastError();
    }
    if (grid_blocks < 0) return;
    Params p{};
    for (int i = 0; i < 21; ++i) p.in[i] = (const float*)d_in[i];
    p.out = (float*)d_out; p.ws = (unsigned char*)d_ws;
    (void)hipMemsetAsync((char*)d_ws + WS_BAR, 0, (XCD_BAR_WORDS + 512) * 4, stream);
    void* args[] = {&p};
    hipError_t e = hipLaunchCooperativeKernel((const void*)mega_fwd, dim3(grid_blocks), dim3(512), args, LDS_BYTES, stream);
    if (e != hipSuccess) fprintf(stderr, "cooperative launch failed: %s (grid %d)\n", hipGetErrorString(e), grid_blocks);
}
```

```cpp
#include <hip/hip_runtime.h>
#include <hip/hip_cooperative_groups.h>
#include <cstdio>
#include <cstdint>
namespace cg = cooperative_groups;

#define LAS __attribute__((address_space(3)))
typedef unsigned short bf16_t;
typedef short bf16x8 __attribute__((ext_vector_type(8)));
typedef short s16x4 __attribute__((ext_vector_type(4)));
typedef float f32x2 __attribute__((ext_vector_type(2)));
typedef float f32x4 __attribute__((ext_vector_type(4)));
typedef float f32x16 __attribute__((ext_vector_type(16)));
typedef unsigned u32x2 __attribute__((ext_vector_type(2)));
typedef unsigned u32x4 __attribute__((ext_vector_type(4)));
typedef int i32x4 __attribute__((ext_vector_type(4)));
typedef int i32x8 __attribute__((ext_vector_type(8)));

constexpr int D = 1024, DEPTH = 4, NCTX = 16, SEQ = 256, NLAT = 8, LSEQ = 1024, PAST = 256;
constexpr int MCTX = NCTX * SEQ, MTOT = MCTX + NLAT * LSEQ;
constexpr int INW = 1280, DFF = 2816, UPW = 2 * DFF;
constexpr int NCOND = 9, MODW = 6 * D;
constexpr float LN_EPS = 1e-5f;
constexpr float ALPHA = 1.681792830507429f;
constexpr float QSCALE = 0.125f * 1.4426950408889634f;
constexpr float LOG2E = 1.4426950408889634f;
constexpr bool OUT_FP8 = true;
constexpr bool DOWN_FP8 = true;
constexpr bool UP_FP8 = false;
constexpr float S_WUP = UP_FP8 ? 64.f : 1.f, S_WDN = DOWN_FP8 ? 256.f : 1.f, S_ACT = DOWN_FP8 ? 8.f : 1.f, S_WOUT = OUT_FP8 ? 64.f : 1.f, S_MIX = OUT_FP8 ? 16.f : 1.f;

constexpr size_t MiB = 1u << 20;
constexpr size_t WS_WIN = 0, WS_WOUT = 10 * MiB, WS_WUP = 18 * MiB, WS_WDN = 62 * MiB, WS_MODS = 84 * MiB, WS_ROPE = 85 * MiB;
constexpr size_t WS_STATS = 85 * MiB + 64 * 1024;
constexpr size_t WS_BAR = 84 * MiB + 900 * 1024;
constexpr size_t WS_KC = 86 * MiB, WS_VCT = 88 * MiB, WS_X = 90 * MiB, WS_H = 138 * MiB;
constexpr size_t WS_Q = 162 * MiB, WS_K = 174 * MiB, WS_VT = 177 * MiB, WS_PP = 180 * MiB, WS_MIX = 204 * MiB;
constexpr size_t WS_HALO = 228 * MiB;
constexpr size_t WS_ACT = 234 * MiB, WS_H8 = 300 * MiB, WS_END = 312 * MiB;
constexpr int VT_LAT_OFF = NCTX * 128 * SEQ;

constexpr int LDS_BYTES = 147456;

struct Params { const float* in[21]; float* out; unsigned char* ws; };
__device__ __forceinline__ const float* inp(const Params& p, int i) { asm volatile("" : "+s"(i)); return (const float*)(const __attribute__((address_space(1))) float*)p.in[i]; }
enum { I_XP = 0, I_XS, I_CK, I_CV, I_C, I_CCTX, I_WMOD, I_BMOD, I_WIN, I_SINK, I_WPOOL, I_PSCALE, I_WOUT, I_LN1G, I_LN1B, I_WUP, I_CONVW, I_CONVB, I_WDOWN, I_LN2G, I_LN2B };

__device__ __forceinline__ unsigned f2bf(float f) { unsigned u = __builtin_bit_cast(unsigned, f); return (u + 0x7fffu + ((u >> 16) & 1u)) >> 16; }
__device__ __forceinline__ unsigned pk2(float lo, float hi) { return f2bf(lo) | (f2bf(hi) << 16); }
__device__ __forceinline__ unsigned pk4_fp8(float a, float b, float c, float d) { int w = 0; w = __builtin_amdgcn_cvt_pk_fp8_f32(a, b, w, false); w = __builtin_amdgcn_cvt_pk_fp8_f32(c, d, w, true); return (unsigned)w; }
__device__ __forceinline__ float bf2f(unsigned short v) { return __builtin_bit_cast(float, (unsigned)v << 16); }
__device__ __forceinline__ float bflo(unsigned v) { return __builtin_bit_cast(float, v << 16); }
__device__ __forceinline__ float bfhi(unsigned v) { return __builtin_bit_cast(float, v & 0xffff0000u); }
#define LDS_WAIT() asm volatile("s_waitcnt lgkmcnt(0)" ::: "memory")
__device__ __forceinline__ float shfl_xor_l(float v, int lane, int m) { return __builtin_bit_cast(float, __builtin_amdgcn_ds_bpermute((lane ^ m) << 2, __builtin_bit_cast(int, v))); }
__device__ __forceinline__ float wave_sum(float v) {
#pragma unroll
    for (int o = 1; o < 64; o <<= 1) v += __shfl_xor(v, o);
    return v;
}
__device__ __forceinline__ int lane_id() { int r; asm volatile("v_mbcnt_lo_u32_b32 %0, -1, 0\n\tv_mbcnt_hi_u32_b32 %0, -1, %0" : "=v"(r)); return r; }
#define TID(wv) ((wv) * 64 + lane_id())
__device__ __forceinline__ int cond_of_row(int row) { return row < MCTX ? 0 : 1 + ((row - MCTX) >> 10); }

namespace pg8 {
constexpr int BM = 256, BK = 64, HALF = 128, HTB = HALF * BK * 2, NXCD = 8, WGM = 6;
__device__ __forceinline__ int lds_byte(int r, int c) { const int st = (r >> 4) * 2 + (c >> 5), rr = r & 15, cc = c & 31, ob = rr * 64 + cc * 2; return st * 1024 + (ob ^ (((ob >> 9) & 1) << 5)); }
__device__ __forceinline__ void stage_rc(int b, int& R, int& C) { const int st = b / 1024, sb = b % 1024, swz = sb ^ (((sb >> 9) & 1) << 5); R = (st >> 1) * 16 + swz / 64; C = (st & 1) * 32 + (swz % 64) / 2; }
__device__ __forceinline__ int perm32(int rho) { const int n = rho >> 4, i = rho & 15; return 8 * (i >> 2) + 4 * n + (i & 3); }
struct Unit { int pm, pn; };
struct Gemm { const bf16_t* A; const bf16_t* Bt; int M, N, K; };
struct StaticOrder {
    int nM, nN, nwg, G, c;
    __device__ void init(int M, int N, int G_, int c_) { nM = M / BM; nN = N / BM; nwg = nM * nN; G = G_; c = c_; }
    __device__ bool next(int i, Unit& u) const {
        const long L = (long)i * G + c; if (L >= nwg) return false;
        int wgid = (int)L; { const int q = nwg / NXCD, r = nwg % NXCD, xcd = wgid % NXCD, off = wgid / NXCD; wgid = (xcd < r ? xcd * (q + 1) : r * (q + 1) + (xcd - r) * q) + off; }
        const int nig = WGM * nN, gid = wgid / nig, fm = gid * WGM, gsz = (nM - fm) < WGM ? (nM - fm) : WGM;
        u.pm = fm + ((wgid % nig) % gsz); u.pn = (wgid % nig) / gsz; return true;
    }
};
__device__ __forceinline__ unsigned cvt_pk_bf16(float lo, float hi) { unsigned r; asm volatile("v_cvt_pk_bf16_f32 %0, %1, %2" : "=v"(r) : "v"(lo), "v"(hi)); return r; }

#define PG8_LANE_FROM_AOFF(aoff, fr, fq) int a__ = (aoff); asm volatile("" : "+v"(a__)); const int fr = (a__ >> 6) & 15, fq = ((a__ >> 4) & 3) ^ ((fr >> 3) << 1)
template <class Epi, class Sched>
__device__ __forceinline__ void gemm_phase(LAS unsigned char* lds, const Gemm g, const Sched& S, const Epi& E, int wv) {
    int tid_ = TID(wv); asm volatile("" : "+v"(tid_));
    const int tid = tid_, wid = __builtin_amdgcn_readfirstlane(tid >> 6), lane = tid & 63, wr = wid >> 2, wc = wid & 3, fr = lane & 15, fq = lane >> 4;
    const int K = g.K, nt = K / BK;
    unsigned voffA, voffB;
    { int R, C; stage_rc(tid * 16, R, C); const int Rb = Epi::PERM ? ((R & ~31) + perm32(R & 31)) : R;
      voffA = (unsigned)(R * K + C) * 2u; voffB = (unsigned)(Rb * K + C) * 2u; }
    const size_t rstep = (size_t)64 * K * 2;
    const size_t kstep = (size_t)(BK * 2);
    const size_t hstep = (size_t)HALF * K * 2;
    const size_t tstep = 2 * hstep;
    const unsigned ldsw = (unsigned)wid * 1024u;
    const int aoff = lds_byte(wr * 64 + fr, fq * 8), boff = lds_byte(wc * 32 + fr, fq * 8);
#define PG8_SA(b, h) (((b) * 2 + (h)) * HTB)
#define PG8_SB(b, h) ((4 + (b) * 2 + (h)) * HTB)
#define PG8_STAGE(bufoff, gbase, voff) do { _Pragma("unroll") for (int _i = 0; _i < 2; ++_i) \
        __builtin_amdgcn_global_load_lds((const unsigned*)((const char*)(gbase) + _i * rstep + (voff)), (LAS unsigned*)(lds + (bufoff) + ldsw + _i * 8192), 16, 0, 0); } while (0)
#define PG8_CAT(x, y) __builtin_shufflevector(__builtin_bit_cast(i32x4, x), __builtin_bit_cast(i32x4, y), 0, 1, 2, 3, 4, 5, 6, 7)
#define PG8_LDA(dst, b, h) do { if constexpr (Epi::FP8) { _Pragma("unroll") for (int m = 0; m < 4; ++m) dst##8[m] = PG8_CAT(*(const LAS bf16x8*)(lds + PG8_SA(b, h) + aoff + m * 2048), *(const LAS bf16x8*)(lds + PG8_SA(b, h) + aoff + m * 2048 + 1024)); } \
        else { _Pragma("unroll") for (int m = 0; m < 4; ++m) _Pragma("unroll") for (int k = 0; k < 2; ++k) dst[m][k] = *(const LAS bf16x8*)(lds + PG8_SA(b, h) + aoff + m * 2048 + k * 1024); } } while (0)
#define PG8_LDB(dst, b, h) do { if constexpr (Epi::FP8) { _Pragma("unroll") for (int n = 0; n < 2; ++n) dst##8[n] = PG8_CAT(*(const LAS bf16x8*)(lds + PG8_SB(b, h) + boff + n * 2048), *(const LAS bf16x8*)(lds + PG8_SB(b, h) + boff + n * 2048 + 1024)); } \
        else { _Pragma("unroll") for (int n = 0; n < 2; ++n) _Pragma("unroll") for (int k = 0; k < 2; ++k) dst[n][k] = *(const LAS bf16x8*)(lds + PG8_SB(b, h) + boff + n * 2048 + k * 1024); } } while (0)
#define PG8_MMA(ai, bj, At, Bt) do { __builtin_amdgcn_s_setprio(1); \
        if constexpr (Epi::FP8) { _Pragma("unroll") for (int m = 0; m < 4; ++m) _Pragma("unroll") for (int n = 0; n < 2; ++n) \
            acc[ai][bj][m][n] = __builtin_amdgcn_mfma_scale_f32_16x16x128_f8f6f4(Bt##8[n], At##8[m], acc[ai][bj][m][n], 0, 0, 0, 0x7f7f7f7f, 0, 0x7f7f7f7f); } \
        else { _Pragma("unroll") for (int m = 0; m < 4; ++m) _Pragma("unroll") for (int n = 0; n < 2; ++n) _Pragma("unroll") for (int k = 0; k < 2; ++k) \
            acc[ai][bj][m][n] = __builtin_amdgcn_mfma_f32_16x16x32_bf16(Bt[n][k], At[m][k], acc[ai][bj][m][n], 0, 0, 0); } \
        __builtin_amdgcn_s_setprio(0); } while (0)
#define PG8_WAIT_V(n) asm volatile("s_waitcnt vmcnt(" #n ")" ::: "memory")
#define PG8_WAIT_L(n) asm volatile("s_waitcnt lgkmcnt(" #n ")" ::: "memory")
#define PG8_BAR __builtin_amdgcn_s_barrier()
#define PG8_SCHED __builtin_amdgcn_sched_barrier(0)
    Unit cur, nxt; int ui = 0;
    if (!S.next(0, cur)) return;
    f32x4 acc[2][2][4][2];
#pragma unroll
    for (int a = 0; a < 2; ++a)
#pragma unroll
        for (int b = 0; b < 2; ++b)
#pragma unroll
            for (int m = 0; m < 4; ++m)
#pragma unroll
                for (int n = 0; n < 2; ++n) acc[a][b][m][n] = (f32x4){0.f, 0.f, 0.f, 0.f};
    bf16x8 At[4][2], B0[2][2], B1[2][2];
    i32x8 At8[4], B08[2], B18[2];
    const char* cA = (const char*)g.A + (size_t)cur.pm * tstep; const char* cB = (const char*)g.Bt + (size_t)cur.pn * tstep;
    PG8_STAGE(PG8_SB(0, 0), cB, voffB); PG8_STAGE(PG8_SB(0, 1), cB + hstep, voffB); PG8_STAGE(PG8_SA(0, 0), cA, voffA); PG8_STAGE(PG8_SA(0, 1), cA + hstep, voffA);
    if (wr == 1) PG8_BAR;
    PG8_WAIT_V(2); PG8_BAR;
    PG8_STAGE(PG8_SB(1, 0), cB + kstep, voffB); PG8_STAGE(PG8_SA(1, 0), cA + kstep, voffA); PG8_STAGE(PG8_SB(1, 1), cB + hstep + kstep, voffB);
    PG8_WAIT_V(6); PG8_BAR;
    for (;;) {
        const bool has_next = Epi::LNF ? false : S.next(ui + 1, nxt);
        const char* nA = has_next ? (const char*)g.A + (size_t)nxt.pm * tstep : cA; const char* nB = has_next ? (const char*)g.Bt + (size_t)nxt.pn * tstep : cB;
#pragma unroll 1
        for (int t = 0; t < nt; t += 2) {
            const bool last = (t == nt - 2);
            const char* a1 = cA + (size_t)(t + 1) * kstep;
            const char* a2 = last ? nA : cA + (size_t)(t + 2) * kstep; const char* b2 = last ? nB : cB + (size_t)(t + 2) * kstep;
            asm volatile("" : "+s"(a1), "+s"(a2), "+s"(b2));
            const char* a3 = a2 + kstep; const char* b3 = b2 + kstep;
            PG8_LDB(B0, 0, 0); PG8_LDB(B1, 0, 1); PG8_SCHED; PG8_LDA(At, 0, 0); PG8_STAGE(PG8_SA(1, 1), a1 + hstep, voffA);
            PG8_WAIT_V(8); PG8_WAIT_L(0); PG8_BAR; PG8_MMA(0, 0, At, B0); PG8_MMA(0, 1, At, B1); PG8_BAR; PG8_SCHED;
            PG8_LDA(At, 0, 1); PG8_STAGE(PG8_SB(0, 0), b2, voffB); PG8_STAGE(PG8_SB(0, 1), b2 + hstep, voffB); PG8_STAGE(PG8_SA(0, 0), a2, voffA);
            PG8_WAIT_V(8); PG8_WAIT_L(0); PG8_BAR; PG8_MMA(1, 0, At, B0); PG8_MMA(1, 1, At, B1); PG8_BAR; PG8_SCHED;
            PG8_LDB(B0, 1, 0); PG8_LDB(B1, 1, 1); PG8_SCHED; PG8_LDA(At, 1, 0); PG8_STAGE(PG8_SA(0, 1), a2 + hstep, voffA);
            PG8_WAIT_V(8); PG8_WAIT_L(0); PG8_BAR; PG8_MMA(0, 0, At, B0); PG8_MMA(0, 1, At, B1); PG8_BAR; PG8_SCHED;
            PG8_LDA(At, 1, 1); PG8_STAGE(PG8_SB(1, 0), b3, voffB); PG8_STAGE(PG8_SB(1, 1), b3 + hstep, voffB); PG8_STAGE(PG8_SA(1, 0), a3, voffA);
            PG8_WAIT_V(8); PG8_WAIT_L(0); PG8_BAR; PG8_MMA(1, 0, At, B0); PG8_MMA(1, 1, At, B1); PG8_BAR; PG8_SCHED;
        }
        if constexpr (Epi::LNF) break;
        if constexpr (Epi::ALIGN) { if (wr == 0) PG8_BAR; E.pre(acc, cur, wr, wc, aoff); PG8_WAIT_L(0); PG8_BAR; }
        E(acc, cur, wr, wc, aoff);
        if (!has_next) break;
#pragma unroll
        for (int a = 0; a < 2; ++a)
#pragma unroll
            for (int b = 0; b < 2; ++b)
#pragma unroll
                for (int m = 0; m < 4; ++m)
#pragma unroll
                    for (int n = 0; n < 2; ++n) acc[a][b][m][n] = (f32x4){0.f, 0.f, 0.f, 0.f};
        cur = nxt; cA = nA; cB = nB; ++ui;
        if constexpr (Epi::ALIGN) { if (wr == 1) PG8_BAR; }
    }
    PG8_WAIT_V(0);
    if constexpr (!Epi::ALIGN) { if (wr == 0) PG8_BAR; }
    PG8_BAR;
    if constexpr (Epi::LNF) E.fused(acc, cur, wr, wc, aoff);
#undef PG8_SA
#undef PG8_SB
#undef PG8_STAGE
#undef PG8_LDA
#undef PG8_LDB
#undef PG8_MMA
#undef PG8_CAT
#undef PG8_WAIT_V
#undef PG8_WAIT_L
#undef PG8_BAR
#undef PG8_SCHED
}
}

#define XB_TMO      128
#define XB_XCNT(j)  (256  + 64 * (j))
#define XB_XSUB(j)  (1280 + 64 * (j))
#define XB_XGEN(j)  (2304 + 64 * (j))
#define XB_TOP      3328
#define XB_TOPGEN   3392
#define XCD_BAR_WORDS 3456
#define XB_SPIN_CAP (1u << 18)
__device__ __forceinline__ unsigned xb_ld(unsigned* p)              { return __hip_atomic_load(p, __ATOMIC_RELAXED, __HIP_MEMORY_SCOPE_AGENT); }
__device__ __forceinline__ unsigned xb_add(unsigned* p, unsigned v) { return __hip_atomic_fetch_add(p, v, __ATOMIC_RELAXED, __HIP_MEMORY_SCOPE_AGENT); }
__device__ __forceinline__ unsigned xb_xcc_id() { return (unsigned)__builtin_amdgcn_s_getreg((3 << 11) | 20) & 0xFu; }
#define XB_SPIN(cond, bar) do { unsigned _sp = 0; while (cond) { __builtin_amdgcn_s_sleep(0); \
    if ((++_sp & 255u) == 0u) { if (xb_ld(&(bar)[XB_TMO])) break; if (_sp > XB_SPIN_CAP) { atomicAdd(&(bar)[XB_TMO], 1u); break; } } } } while (0)
__device__ __forceinline__ void xcd_barrier_post(unsigned* bar, int wv) {
    if (wv == 0 && lane_id() == 0) (void)xb_add(&bar[XB_XCNT(xb_xcc_id())], 1u);
}
__device__ __forceinline__ void xcd_barrier_complete(unsigned* bar, unsigned x, unsigned& nloc, unsigned& nx) {
    const unsigned G = gridDim.x * gridDim.y * gridDim.z;
    unsigned sum, cnt, sp = 0u;
    for (;;) {
        sum = 0u; cnt = 0u;
#pragma unroll 1
        for (unsigned j = 0; j < 16; ++j) { const unsigned c = xb_ld(&bar[XB_XCNT(j)]); sum += c; cnt += (c > 0u) ? 1u : 0u; }
        if (sum == G) break;
        __builtin_amdgcn_s_sleep(1);
        if ((++sp & 255u) == 0u) { if (xb_ld(&bar[XB_TMO])) break; if (sp > XB_SPIN_CAP) { atomicAdd(&bar[XB_TMO], 1u); break; } }
    }
    const unsigned mine = xb_ld(&bar[XB_XCNT(x)]);
    nloc = mine > 0u ? mine : 1u; nx = cnt > 0u ? cnt : 1u;
}
__device__ __forceinline__ void xcd_barrier_leader(unsigned* bar, volatile LAS unsigned* st) {
    const unsigned x = xb_xcc_id();
    __builtin_amdgcn_s_waitcnt(0);
    unsigned nloc = st[0], nx = st[1];
    if (nloc == 0u) { xcd_barrier_complete(bar, x, nloc, nx); st[0] = nloc; st[1] = nx; }
    const unsigned old = xb_add(&bar[XB_XSUB(x)], 1u);
    const unsigned gen = old / nloc;
    if (old + 1u == (gen + 1u) * nloc) {
        __builtin_amdgcn_fence(__ATOMIC_RELEASE, "agent");
        asm volatile("s_waitcnt vmcnt(0)" ::: "memory");
        const unsigned og = xb_add(&bar[XB_TOP], 1u);
        const unsigned tg = og / nx;
        if (og + 1u == (tg + 1u) * nx) xb_add(&bar[XB_TOPGEN], 1u);
        else XB_SPIN(xb_ld(&bar[XB_TOPGEN]) == tg, bar);
        __builtin_amdgcn_fence(__ATOMIC_ACQUIRE, "agent");
        xb_add(&bar[XB_XGEN(x)], 1u);
        asm volatile("s_waitcnt vmcnt(0)" ::: "memory");
    } else {
        XB_SPIN(xb_ld(&bar[XB_XGEN(x)]) == gen, bar);
        __builtin_amdgcn_fence(__ATOMIC_ACQUIRE, "agent");
        asm volatile("s_waitcnt vmcnt(0)" ::: "memory");
    }
}
__device__ __forceinline__ void xcd_barrier(unsigned* bar, volatile LAS unsigned* st, int wv) {
    asm volatile("s_waitcnt vmcnt(0)" ::: "memory");
    __syncthreads();
    if (wv == 0 && lane_id() == 0) xcd_barrier_leader(bar, st);
    __syncthreads();
}

struct EpiIn {
    static constexpr bool PERM = false, ALIGN = false, LNF = false, FP8 = false;
    int l; bf16_t *Q, *Kb, *VT; float* PP; const float* rope; float *outk, *outv;
    __device__ __forceinline__ void operator()(const f32x4 (&acc)[2][2][4][2], const pg8::Unit& u, int wr, int wc, int aoff) const {
        PG8_LANE_FROM_AOFF(aoff, fr, fq);
        const bool lat = u.pm >= 16;
#pragma unroll
        for (int ai = 0; ai < 2; ++ai)
#pragma unroll
            for (int m = 0; m < 4; ++m) {
                const int row = u.pm * 256 + ai * 128 + wr * 64 + m * 16 + fr;
                f32x4 c4 = {1.f, 1.f, 1.f, 1.f}, s4 = {0.f, 0.f, 0.f, 0.f};
                if (lat && u.pn <= 2) {
                    const int t = (row - MCTX) & 1023; const int pos = (wc & 1) ? (t & 63) : (t >> 6);
                    const float* rp = rope + (pos * 16 + 4 * fq) * 2;
                    const f32x4 a = *(const f32x4*)rp, b = *(const f32x4*)(rp + 4);
                    c4 = (f32x4){a.x, a.z, b.x, b.z}; s4 = (f32x4){a.y, a.w, b.y, b.w};
                }
                if (u.pn < 2) {
#pragma unroll
                    for (int bj = 0; bj < 2; ++bj) {
                        const int col = u.pn * 256 + bj * 128 + wc * 32 + 4 * fq;
                        const f32x4 x1 = acc[ai][bj][m][0], x2 = acc[ai][bj][m][1];
                        const f32x4 o1 = (x1 * c4 - x2 * s4) * QSCALE, o2 = (x2 * c4 + x1 * s4) * QSCALE;
                        bf16_t* qp = Q + (size_t)row * 512 + col;
                        *(u32x2*)qp = (u32x2){pg8::cvt_pk_bf16(o1.x, o1.y), pg8::cvt_pk_bf16(o1.z, o1.w)};
                        *(u32x2*)(qp + 16) = (u32x2){pg8::cvt_pk_bf16(o2.x, o2.y), pg8::cvt_pk_bf16(o2.z, o2.w)};
                    }
                } else if (u.pn == 2) {
                    const int kc = wc * 32 + 4 * fq;
                    {
                        const f32x4 x1 = acc[ai][0][m][0], x2 = acc[ai][0][m][1];
                        if (!lat) { float* ok = outk + ((size_t)((row >> 8) * DEPTH + l) * SEQ + (row & 255)) * 128 + kc; __builtin_nontemporal_store(x1, (f32x4*)ok); __builtin_nontemporal_store(x2, (f32x4*)(ok + 16)); }
                        const f32x4 o1 = x1 * c4 - x2 * s4, o2 = x2 * c4 + x1 * s4;
                        bf16_t* kp = Kb + (size_t)row * 128 + kc;
                        *(u32x2*)kp = (u32x2){pg8::cvt_pk_bf16(o1.x, o1.y), pg8::cvt_pk_bf16(o1.z, o1.w)};
                        *(u32x2*)(kp + 16) = (u32x2){pg8::cvt_pk_bf16(o2.x, o2.y), pg8::cvt_pk_bf16(o2.z, o2.w)};
                    }
                    {
                        const f32x4 v1 = acc[ai][1][m][0], v2 = acc[ai][1][m][1];
                        bf16_t* vt; int T;
                        if (!lat) { float* ov = outv + ((size_t)((row >> 8) * DEPTH + l) * SEQ + (row & 255)) * 128 + kc; __builtin_nontemporal_store(v1, (f32x4*)ov); __builtin_nontemporal_store(v2, (f32x4*)(ov + 16));
                            T = SEQ; vt = VT + (size_t)((row >> 8) * 128 + kc) * SEQ + (row & 255); }
                        else { const int r2 = row - MCTX; T = LSEQ; vt = VT + VT_LAT_OFF + (size_t)((r2 >> 10) * 128 + kc) * LSEQ + (r2 & 1023); }
#pragma unroll
                        for (int i = 0; i < 4; ++i) { vt[(size_t)i * T] = (bf16_t)f2bf(v1[i]); vt[(size_t)(16 + i) * T] = (bf16_t)f2bf(v2[i]); }
                    }
                } else {
#pragma unroll
                    for (int bj = 0; bj < 2; ++bj)
#pragma unroll
                        for (int n = 0; n < 2; ++n) {
                            const int pc = (u.pn - 3) * 256 + bj * 128 + wc * 32 + 16 * n + 4 * fq;
                            *(f32x4*)(PP + (size_t)row * 512 + pc) = acc[ai][bj][m][n];
                        }
                }
            }
    }
};

constexpr int ST_WT = 0;
constexpr int XCH_OFF = 131072 + 1024;
template <bool F8IN  , bool H8  >
struct EpiLn {
    static constexpr bool PERM = true, ALIGN = false, LNF = true, FP8 = F8IN;
    float* X; const float* gate; const float* gam; const float* bet; const float* msh; const float* msc; bf16_t* H; float* out; float accs;
    unsigned long long* stats; unsigned* cnt; unsigned* tmo; LAS unsigned char* lds;
    __device__ __forceinline__ void operator()(const f32x4 (&)[2][2][4][2], const pg8::Unit&, int, int, int) const {}
    __device__ __forceinline__ void pre(const f32x4 (&)[2][2][4][2], const pg8::Unit&, int, int, int) const {}
    __device__ __forceinline__ void fused(f32x4 (&y)[2][2][4][2], const pg8::Unit& u, int wr, int wc, int aoff) const {
        PG8_LANE_FROM_AOFF(aoff, fr, fq);
        const int lane_ = fq * 16 + fr, tid = (wr * 4 + wc) * 64 + lane_;
        LAS float* RS = (LAS float*)(lds + XCH_OFF);
        LAS float* RQ = RS + 1024;
        const int cond = u.pm < 16 ? 0 : 1 + ((u.pm - 16) >> 2);
        const int colb = u.pn * 256 + wc * 32 + 8 * fq;
        const unsigned roff = (unsigned)((u.pm * 256 + wr * 64 + fr) * D + colb) * 4u;
        const __amdgpu_buffer_rsrc_t rX = __builtin_amdgcn_make_buffer_rsrc(X, 0, 0x7fffffff, 0x00020000);
        const __amdgpu_buffer_rsrc_t rO = __builtin_amdgcn_make_buffer_rsrc(out ? out : X, 0, 0x7fffffff, 0x00020000);
        const __amdgpu_buffer_rsrc_t rH = __builtin_amdgcn_make_buffer_rsrc(H, 0, 0x7fffffff, 0x00020000);
        f32x4 gv[2][2];
#pragma unroll
        for (int bj = 0; bj < 2; ++bj) { const float* g = gate + (size_t)cond * MODW + colb + bj * 128; gv[bj][0] = *(const f32x4*)g; gv[bj][1] = *(const f32x4*)(g + 4);
            if (F8IN) { gv[bj][0] = gv[bj][0] * accs; gv[bj][1] = gv[bj][1] * accs; } }
#pragma unroll
        for (int ai = 0; ai < 2; ++ai)
#pragma unroll
            for (int m = 0; m < 4; ++m) {
                float sv = 0.f;
#pragma unroll
                for (int bj = 0; bj < 2; ++bj) {
                    const int so = ((ai * 128 + m * 16) * D + bj * 128) * 4;
                    const f32x4 xa = __builtin_bit_cast(f32x4, __builtin_amdgcn_raw_buffer_load_b128(rX, roff, so, 0)), xb = __builtin_bit_cast(f32x4, __builtin_amdgcn_raw_buffer_load_b128(rX, roff + 16u, so, 0));
                    const f32x4 v0 = xa * ALPHA + gv[bj][0] * y[ai][bj][m][0], v1 = xb * ALPHA + gv[bj][1] * y[ai][bj][m][1];
                    y[ai][bj][m][0] = v0; y[ai][bj][m][1] = v1;
                    sv += ((v0.x + v0.y) + (v0.z + v0.w)) + ((v1.x + v1.y) + (v1.z + v1.w));
                }
                sv += shfl_xor_l(sv, lane_, 16); sv += shfl_xor_l(sv, lane_, 32);
                if (fq == 0) RS[wc * 256 + ai * 128 + wr * 64 + m * 16 + fr] = sv;
                if (m == 3) asm volatile("" ::: "memory");
            }
        __syncthreads();
#pragma unroll
        for (int ai = 0; ai < 2; ++ai)
#pragma unroll
            for (int m = 0; m < 4; ++m) {
                const int rl = ai * 128 + wr * 64 + m * 16 + fr;
                const float mu = ((RS[rl] + RS[256 + rl]) + (RS[512 + rl] + RS[768 + rl])) * (1.f / 256.f);
                float q = 0.f;
#pragma unroll
                for (int bj = 0; bj < 2; ++bj)
#pragma unroll
                    for (int n = 0; n < 2; ++n) { const f32x4 v = y[ai][bj][m][n] - mu; q += (v.x * v.x + v.y * v.y) + (v.z * v.z + v.w * v.w); }
                q += shfl_xor_l(q, lane_, 16); q += shfl_xor_l(q, lane_, 32);
                if (fq == 0) RQ[wc * 256 + rl] = q;
            }
        __syncthreads();
        if (tid < 256) {
            const float sm = (RS[tid] + RS[256 + tid]) + (RS[512 + tid] + RS[768 + tid]);
            const float m2 = (RQ[tid] + RQ[256 + tid]) + (RQ[512 + tid] + RQ[768 + tid]);
            const unsigned long long v = (unsigned long long)__builtin_bit_cast(unsigned, sm) | ((unsigned long long)__builtin_bit_cast(unsigned, m2) << 32);
            __hip_atomic_store(stats + ((size_t)(u.pm * 4 + u.pn) * 256 + tid), v, __ATOMIC_RELAXED, __HIP_MEMORY_SCOPE_AGENT);
        }
        asm volatile("s_waitcnt vmcnt(0)" ::: "memory");
        __syncthreads();
        if (tid == 0) {
            (void)xb_add(cnt + u.pm, 1u);
            unsigned sp = 0;
            while (xb_ld(cnt + u.pm) < 4u) { __builtin_amdgcn_s_sleep(0); if (++sp > (1u << 22)) { atomicAdd(tmo, 1u); break; } }
        }
        __syncthreads();
        if (tid < 256) {
            float sj[4], mj[4];
#pragma unroll
            for (int j = 0; j < 4; ++j) { const unsigned long long v = __hip_atomic_load(stats + ((size_t)(u.pm * 4 + j) * 256 + tid), __ATOMIC_RELAXED, __HIP_MEMORY_SCOPE_AGENT);
                sj[j] = __builtin_bit_cast(float, (unsigned)(v & 0xffffffffull)); mj[j] = __builtin_bit_cast(float, (unsigned)(v >> 32)); }
            const float mean = ((sj[0] + sj[1]) + (sj[2] + sj[3])) * (1.f / D);
            float m2 = (mj[0] + mj[1]) + (mj[2] + mj[3]);
#pragma unroll
            for (int j = 0; j < 4; ++j) { const float dm = sj[j] * (1.f / 256.f) - mean; m2 += 256.f * dm * dm; }
            RS[tid] = mean; RQ[tid] = 1.f / sqrtf(m2 * (1.f / D) + LN_EPS);
        }
        __syncthreads();
#pragma unroll
        for (int bj = 0; bj < 2; ++bj) {
            const int col = colb + bj * 128;
            const f32x4 ga0 = *(const f32x4*)(gam + col), ga1 = *(const f32x4*)(gam + col + 4), be0 = *(const f32x4*)(bet + col), be1 = *(const f32x4*)(bet + col + 4);
            f32x4 sc0 = {0.f, 0.f, 0.f, 0.f}, sc1 = sc0, sh0 = sc0, sh1 = sc0;
            if (!out) { const float* ms = msc + (size_t)cond * MODW + col; const float* mh = msh + (size_t)cond * MODW + col;
                sc0 = *(const f32x4*)ms + 1.f; sc1 = *(const f32x4*)(ms + 4) + 1.f; sh0 = *(const f32x4*)mh; sh1 = *(const f32x4*)(mh + 4); }
#pragma unroll
            for (int ai = 0; ai < 2; ++ai) {
#pragma unroll
                for (int m = 0; m < 4; ++m) {
                    const int rl = ai * 128 + wr * 64 + m * 16 + fr;
                    const int so = ((ai * 128 + m * 16) * D + bj * 128) * 4;
                    const float mean = RS[rl], rstd = RQ[rl];
                    const f32x4 x0 = (y[ai][bj][m][0] - mean) * rstd * ga0 + be0, x1 = (y[ai][bj][m][1] - mean) * rstd * ga1 + be1;
                    if (out) { __builtin_amdgcn_raw_buffer_store_b128(__builtin_bit_cast(u32x4, x0), rO, roff, so, 2); __builtin_amdgcn_raw_buffer_store_b128(__builtin_bit_cast(u32x4, x1), rO, roff + 16u, so, 2); }
                    else { __builtin_amdgcn_raw_buffer_store_b128(__builtin_bit_cast(u32x4, x0), rO, roff, so, ST_WT); __builtin_amdgcn_raw_buffer_store_b128(__builtin_bit_cast(u32x4, x1), rO, roff + 16u, so, ST_WT); }
                    if (!out) {
                        const f32x4 h0 = x0 * sc0 + sh0, h1 = x1 * sc1 + sh1;
                        if (H8) { __builtin_amdgcn_raw_buffer_store_b64((u32x2){pk4_fp8(h0.x, h0.y, h0.z, h0.w), pk4_fp8(h1.x, h1.y, h1.z, h1.w)}, rH, roff >> 2, so >> 2, ST_WT); }
                        else { u32x4 w; w.x = pg8::cvt_pk_bf16(h0.x, h0.y); w.y = pg8::cvt_pk_bf16(h0.z, h0.w); w.z = pg8::cvt_pk_bf16(h1.x, h1.y); w.w = pg8::cvt_pk_bf16(h1.z, h1.w);
                            __builtin_amdgcn_raw_buffer_store_b128(w, rH, roff >> 1, so >> 1, ST_WT); } }
                }
                __builtin_amdgcn_sched_barrier(0);
            }
        }
    }
};

#define DPP_F(old, src, ctrl) __builtin_bit_cast(float, __builtin_amdgcn_update_dpp(__builtin_bit_cast(int, (float)(old)), __builtin_bit_cast(int, (float)(src)), (ctrl), 0xF, 0xF, false))
struct EpiUpConv {
    static constexpr bool PERM = true, ALIGN = true, LNF = false, FP8 = UP_FP8;
    unsigned char* ACT; float* HALO; const float* cw; const float* cb; LAS unsigned char* lds;
    __device__ __forceinline__ void pre(const f32x4 (&acc)[2][2][4][2], const pg8::Unit& u, int wr, int wc, int aoff) const {
        PG8_LANE_FROM_AOFF(aoff, fr, fq);
        LAS float* XF = (LAS float*)(lds + XCH_OFF); LAS float* XL = XF + 1024;
        const int colw = wc * 32 + 8 * fq;
        if (fr == 0) {
#pragma unroll
            for (int ai = 0; ai < 2; ++ai)
#pragma unroll
                for (int bj = 0; bj < 2; ++bj)
#pragma unroll
                    for (int n = 0; n < 2; ++n) *(LAS f32x4*)(XF + (2 * ai + wr) * 256 + bj * 128 + colw + 4 * n) = acc[ai][bj][0][n];
        }
        if (fr == 15) {
#pragma unroll
            for (int ai = 0; ai < 2; ++ai)
#pragma unroll
                for (int bj = 0; bj < 2; ++bj)
#pragma unroll
                    for (int n = 0; n < 2; ++n) *(LAS f32x4*)(XL + (2 * ai + wr) * 256 + bj * 128 + colw + 4 * n) = acc[ai][bj][3][n];
        }
        if (u.pm >= 16) {
            float* hb = HALO + (size_t)u.pm * 4 * UPW + u.pn * 256 + colw;
            if (wr == 0 && fr < 2) {
#pragma unroll
                for (int bj = 0; bj < 2; ++bj)
#pragma unroll
                    for (int n = 0; n < 2; ++n) *(f32x4*)(hb + (size_t)fr * UPW + bj * 128 + 4 * n) = acc[0][bj][0][n];
            }
            if (wr == 1 && fr >= 14) {
#pragma unroll
                for (int bj = 0; bj < 2; ++bj)
#pragma unroll
                    for (int n = 0; n < 2; ++n) *(f32x4*)(hb + (size_t)(fr - 12) * UPW + bj * 128 + 4 * n) = acc[1][bj][3][n];
            }
        }
    }
    __device__ __forceinline__ void operator()(const f32x4 (&acc)[2][2][4][2], const pg8::Unit& u, int wr, int wc, int aoff) const {
        PG8_LANE_FROM_AOFF(aoff, fr, fq);
        const LAS float* XF = (const LAS float*)(lds + XCH_OFF); const LAS float* XL = XF + 1024;
        const int colw = wc * 32 + 8 * fq;
        const int ch0 = u.pn * 128 + colw;
#pragma unroll
        for (int n = 0; n < 2; ++n) {
            const int ch = ch0 + 4 * n;
            f32x4 w[2][3], bs[2];
#pragma unroll
            for (int bj = 0; bj < 2; ++bj) {
#pragma unroll
                for (int k = 0; k < 3; ++k) w[bj][k] = *(const f32x4*)(cw + k * UPW + bj * DFF + ch);
                bs[bj] = *(const f32x4*)(cb + bj * DFF + ch);
            }
#pragma unroll
            for (int ai = 0; ai < 2; ++ai) {
                const int blk = 2 * ai + wr;
                f32x4 cv[2][4];
#pragma unroll
                for (int bj = 0; bj < 2; ++bj) {
                    f32x4 bp = {0.f, 0.f, 0.f, 0.f}, bn = {0.f, 0.f, 0.f, 0.f};
                    if (blk > 0) bp = *(const LAS f32x4*)(XL + (blk - 1) * 256 + bj * 128 + colw + 4 * n);
                    if (blk < 3) bn = *(const LAS f32x4*)(XF + (blk + 1) * 256 + bj * 128 + colw + 4 * n);
#pragma unroll
                    for (int m = 0; m < 4; ++m) {
                        const f32x4 v = acc[ai][bj][m][n];
                        f32x4 P, N;
#pragma unroll
                        for (int i = 0; i < 4; ++i) {
                            const float po = m == 0 ? bp[i] : DPP_F(0.f, acc[ai][bj][m == 0 ? 0 : m - 1][n][i], 0x121);
                            const float no = m == 3 ? bn[i] : DPP_F(0.f, acc[ai][bj][m == 3 ? 3 : m + 1][n][i], 0x12F);
                            P[i] = DPP_F(po, v[i], 0x111);
                            N[i] = DPP_F(no, v[i], 0x101);
                        }
                        cv[bj][m] = (w[bj][0] * P + w[bj][1] * v + w[bj][2] * N) * (1.f / S_WUP) + bs[bj];
                    }
                }
#pragma unroll
                for (int m = 0; m < 4; ++m) {
                    const int row = u.pm * 256 + ai * 128 + wr * 64 + m * 16 + fr;
                    const f32x4 a = cv[0][m], g = cv[1][m];
                    f32x4 r;
#pragma unroll
                    for (int i = 0; i < 4; ++i) r[i] = g[i] * __builtin_amdgcn_rcpf(1.f + __expf(-g[i])) * a[i] * S_ACT;
                    if (u.pm >= 16 && ((ai == 0 && m == 0 && wr == 0 && fr == 0 && ((u.pm - 16) & 3) != 0) || (ai == 1 && m == 3 && wr == 1 && fr == 15 && ((u.pm - 16) & 3) != 3))) continue;
                    if (DOWN_FP8) *(unsigned*)(ACT + (size_t)row * DFF + ch) = pk4_fp8(r.x, r.y, r.z, r.w);
                    else *(u32x2*)(ACT + ((size_t)row * DFF + ch) * 2) = (u32x2){pg8::cvt_pk_bf16(r.x, r.y), pg8::cvt_pk_bf16(r.z, r.w)};
                }
            }
        }
    }
};

template <int MODE>
__device__ __forceinline__ void transpose_item(const float* W, int npitch, int nblk, bf16_t* WT, int ldk, LAS float* scr, int item, int lane) {
    const int kb = item / nblk, nb = item % nblk, k0 = 64 * kb, n0 = 32 * nb;
    float tv[32];
#pragma unroll
    for (int i = 0; i < 32; ++i) tv[i] = __builtin_nontemporal_load(&W[(size_t)(k0 + 2 * i + (lane >> 5)) * npitch + n0 + (lane & 31)]);
#pragma unroll
    for (int i = 0; i < 32; ++i) scr[(2 * i + (lane >> 5)) * 33 + (lane & 31)] = tv[i];
    LDS_WAIT();
    const int c = lane & 7;
#pragma unroll
    for (int j = 0; j < 4; ++j) { const int n = (lane >> 3) + 8 * j; const LAS float* s = scr + (8 * c) * 33 + n;
        const int nn = n0 + n;
        int drow = nn;
        if (MODE == 1 || MODE == 2) { drow = nn < DFF ? (nn >> 7) * 256 + (nn & 127) : ((nn - DFF) >> 7) * 256 + 128 + ((nn - DFF) & 127); }
        if (MODE >= 2) {
            const float sc_ = MODE == 2 ? S_WUP : (MODE == 3 ? S_WDN : S_WOUT);
            *(u32x2*)((unsigned char*)WT + (size_t)drow * ldk + k0 + 8 * c) = (u32x2){pk4_fp8(s[0 * 33] * sc_, s[1 * 33] * sc_, s[2 * 33] * sc_, s[3 * 33] * sc_), pk4_fp8(s[4 * 33] * sc_, s[5 * 33] * sc_, s[6 * 33] * sc_, s[7 * 33] * sc_)};
        } else {
            u32x4 o; o.x = pk2(s[0 * 33], s[1 * 33]); o.y = pk2(s[2 * 33], s[3 * 33]); o.z = pk2(s[4 * 33], s[5 * 33]); o.w = pk2(s[6 * 33], s[7 * 33]);
            *(u32x4*)(WT + (size_t)drow * ldk + k0 + 8 * c) = o; } }
    LDS_WAIT();
}

enum { PREP_MODS = 1, PREP_FOLD = 2, PREP_W0 = 4, PREP_W1 = 8, PREP_MISC = 16 };
__device__ __forceinline__ void prep_items(const Params& p, LAS unsigned char* lds, int wv, int L, int what, int bj, int nb) {
    int tid_ = TID(wv); asm volatile("" : "+v"(tid_));
    const int tid = tid_, lane = tid & 63, wave = wv;
    unsigned char* ws = p.ws;
    float* mods = (float*)(ws + WS_MODS);
    if ((what & PREP_MISC) && bj == 0) {
        float* rope = (float*)(ws + WS_ROPE);
        for (int idx = tid; idx < 1024; idx += 512) {
            const int pos = idx >> 4, i = idx & 15;
            const float inv = exp2f(-(float)i * (13.287712379549449f / 16.f));
            float ang = (float)pos * inv;
            const float k = rintf(ang * 0.15915494309189535f);
            ang = fmaf(-k, 6.28318548202514648f, ang); ang = fmaf(-k, -1.74845553e-07f, ang);
            rope[idx * 2] = __cosf(ang); rope[idx * 2 + 1] = __sinf(ang);
        }
    }
    const int b_lo = (what & PREP_MODS) ? 0 : 96, b_hi = (what & PREP_FOLD) ? 224 : 96;
    for (int it = b_lo + bj; it < b_hi; it += nb) {
        const int l = L;
        if (it < 96) {
            LAS float* sc = (LAS float*)lds;
            LAS float* part = (LAS float*)(lds + 36864);
            __syncthreads();
            for (int idx = tid; idx < NCOND * D; idx += 512) { const int c = idx >> 10, k = idx & 1023;
                const float v = c == 0 ? p.in[I_CCTX][k] : p.in[I_C][(c - 1) * D + k]; sc[idx] = v / (1.f + __expf(-v)); }
            __syncthreads();
            const int n0 = it * 64;
            float a0[NCOND];
#pragma unroll
            for (int c = 0; c < NCOND; ++c) a0[c] = 0.f;
            const float* wp = p.in[I_WMOD] + ((size_t)l * D + wave * 128) * MODW + n0 + lane;
            for (int k = 0; k < 128; k += 16) {
                float w[16];
#pragma unroll
                for (int j = 0; j < 16; ++j) w[j] = __builtin_nontemporal_load(&wp[(size_t)(k + j) * MODW]);
#pragma unroll
                for (int q = 0; q < 4; ++q)
#pragma unroll
                    for (int c = 0; c < NCOND; ++c) { const f32x4 s = *(const LAS f32x4*)(sc + c * D + wave * 128 + k + 4 * q);
                        a0[c] += s.x * w[4 * q] + s.y * w[4 * q + 1] + s.z * w[4 * q + 2] + s.w * w[4 * q + 3]; }
            }
#pragma unroll
            for (int c = 0; c < NCOND; ++c) part[(wave * NCOND + c) * 64 + lane] = a0[c];
            __syncthreads();
            for (int idx = tid; idx < NCOND * 64; idx += 512) { const int c = idx >> 6, j = idx & 63; float s = p.in[I_BMOD][l * MODW + n0 + j];
#pragma unroll
                for (int w = 0; w < 8; ++w) s += part[(w * NCOND + c) * 64 + j];
                mods[(size_t)(l * NCOND + c) * MODW + n0 + j] = s; }
            __syncthreads();
        } else {
            const int f = it - 96, g = (f >> 5) & 3, k0 = (f & 31) * 32;
            LAS float* Wp = (LAS float*)lds;
            LAS float* As = (LAS float*)(lds + 65536);
            __syncthreads();
            const float* wpool = p.in[I_WPOOL] + (size_t)(l * 4 + g) * 16384;
#pragma unroll
            for (int j = 0; j < 8; ++j) *(LAS f32x4*)(Wp + (tid + 512 * j) * 4) = *(const f32x4*)(wpool + (tid + 512 * j) * 4);
#pragma unroll
            for (int j = 0; j < 2; ++j) { const int e = tid + 512 * j, kk = e >> 5, c4 = (e & 31) * 4;
                *(LAS f32x4*)(As + kk * 132 + c4) = *(const f32x4*)(p.in[I_WIN] + ((size_t)l * D + k0 + kk) * INW + 768 + g * 128 + c4); }
            __syncthreads();
            const int j = tid & 127, kq = tid >> 7;
            float acc[8];
#pragma unroll
            for (int i = 0; i < 8; ++i) acc[i] = 0.f;
            for (int c = 0; c < 128; c += 4) {
                const float w0 = Wp[(c + 0) * 128 + j], w1 = Wp[(c + 1) * 128 + j], w2 = Wp[(c + 2) * 128 + j], w3 = Wp[(c + 3) * 128 + j];
#pragma unroll
                for (int i = 0; i < 8; ++i) { const f32x4 a = *(const LAS f32x4*)(As + (kq * 8 + i) * 132 + c); acc[i] += a.x * w0 + a.y * w1 + a.z * w2 + a.w * w3; }
            }
            const float ps = p.in[I_PSCALE][l * 512 + g * 128 + j];
            u32x4 o; o.x = pk2(acc[0] * ps, acc[1] * ps); o.y = pk2(acc[2] * ps, acc[3] * ps); o.z = pk2(acc[4] * ps, acc[5] * ps); o.w = pk2(acc[6] * ps, acc[7] * ps);
            *(u32x4*)((bf16_t*)(ws + WS_WIN) + ((size_t)l * INW + 768 + g * 128 + j) * D + k0 + kq * 8) = o;
            __syncthreads();
        }
    }
    __syncthreads();
    LAS float* scr = (LAS float*)(lds + wave * 16384);
    const int gw = bj * 8 + wave, NGW = nb * 8;
    constexpr int I_IN = 16 * 24, I_OUT = 16 * 32, I_UP = 16 * 176, I_DN = 44 * 32, PER_L = I_IN + I_OUT + I_UP + I_DN;
    constexpr int N_CV = 32 * 16, N_CK = 2048;
    const int w_lo = (what & PREP_W0) ? 0 : ((what & PREP_W1) ? PER_L / 2 : PER_L), w_hi = (what & PREP_MISC) ? PER_L + N_CV + N_CK : ((what & PREP_W1) ? PER_L : ((what & PREP_W0) ? PER_L / 2 : 0));
    for (int it = w_lo + gw; it < w_hi; it += NGW) {
        if (it < PER_L) {
            if (!(what & PREP_W1) && it >= PER_L / 2) continue;
            const int l = L; int r = it;
            if (r < I_IN) { transpose_item<0>(p.in[I_WIN] + (size_t)l * D * INW, INW, 24, (bf16_t*)(ws + WS_WIN) + (size_t)l * INW * D, D, scr, r, lane); continue; } r -= I_IN;
            if (r < I_OUT) { if (OUT_FP8) transpose_item<4>(p.in[I_WOUT] + (size_t)l * D * D, D, 32, (bf16_t*)(ws + WS_WOUT + (size_t)l * D * D), D, scr, r, lane);
                             else transpose_item<0>(p.in[I_WOUT] + (size_t)l * D * D, D, 32, (bf16_t*)(ws + WS_WOUT) + (size_t)l * D * D, D, scr, r, lane); continue; } r -= I_OUT;
            if (r < I_UP) { if (UP_FP8) transpose_item<2>(p.in[I_WUP] + (size_t)l * D * UPW, UPW, 176, (bf16_t*)(ws + WS_WUP + (size_t)l * UPW * D), D, scr, r, lane);
                            else transpose_item<1>(p.in[I_WUP] + (size_t)l * D * UPW, UPW, 176, (bf16_t*)(ws + WS_WUP) + (size_t)l * UPW * D, D, scr, r, lane); continue; } r -= I_UP;
            if (DOWN_FP8) transpose_item<3>(p.in[I_WDOWN] + (size_t)l * DFF * D, D, 32, (bf16_t*)(ws + WS_WDN + (size_t)l * D * DFF), DFF, scr, r, lane);
            else transpose_item<0>(p.in[I_WDOWN] + (size_t)l * DFF * D, D, 32, (bf16_t*)(ws + WS_WDN) + (size_t)l * D * DFF, DFF, scr, r, lane);
        } else if (it < PER_L + N_CV) {
            const int f = it - PER_L, bl = f >> 4, b = bl >> 2, l = bl & 3;
            transpose_item<0>(p.in[I_CV] + (size_t)(b * DEPTH + l) * PAST * 128, 128, 4, (bf16_t*)(ws + WS_VCT) + (size_t)(l * NLAT + b) * 128 * PAST, PAST, scr, f & 15, lane);
        } else {
            const int f = it - PER_L - N_CV; const int e0 = f * 512 + lane * 8, lb = e0 >> 15, rem = e0 & 32767, l = lb >> 3, b = lb & 7;
            const float* s = p.in[I_CK] + (size_t)(b * DEPTH + l) * 32768 + rem;
            const f32x4 v0 = __builtin_nontemporal_load((const f32x4*)s), v1 = __builtin_nontemporal_load((const f32x4*)(s + 4));
            u32x4 o; o.x = pk2(v0.x, v0.y); o.y = pk2(v0.z, v0.w); o.z = pk2(v1.x, v1.y); o.w = pk2(v1.z, v1.w);
            *(u32x4*)((bf16_t*)(ws + WS_KC) + e0) = o;
        }
    }
    __syncthreads();
}

__device__ __forceinline__ void prologue_b(const Params& p, int wv) {
    const int lane = lane_id(), gw = blockIdx.x * 8 + wv, NGW = gridDim.x * 8;
    const float* mods = (const float*)(p.ws + WS_MODS);
    float* X = (float*)(p.ws + WS_X); bf16_t* H = (bf16_t*)(p.ws + WS_H);
    for (int row = gw; row < MTOT; row += NGW) {
        const float* src = row < MCTX ? p.in[I_XP] + (size_t)row * D : p.in[I_XS] + (size_t)(row - MCTX) * D;
        const float* md = mods + (size_t)cond_of_row(row) * MODW;
#pragma unroll
        for (int j = 0; j < 4; ++j) { const int col = 4 * lane + 256 * j;
            const f32x4 v = __builtin_nontemporal_load((const f32x4*)(src + col)), sh = *(const f32x4*)(md + col), sc = *(const f32x4*)(md + D + col);
            *(f32x4*)(X + (size_t)row * D + col) = v;
            const f32x4 h = v * (sc + 1.f) + sh;
            *(u32x2*)(H + (size_t)row * D + col) = (u32x2){pk2(h.x, h.y), pk2(h.z, h.w)}; }
    }
}

__device__ __forceinline__ void convfix_pass(const Params& p, int l, int wv) {
    const float* HALO = (const float*)(p.ws + WS_HALO); unsigned char* ACT = p.ws + WS_ACT;
    const float* cw = p.in[I_CONVW] + (size_t)l * 3 * UPW; const float* cb = p.in[I_CONVB] + (size_t)l * UPW;
    int tid_ = TID(wv); asm volatile("" : "+v"(tid_));
    const int gt = blockIdx.x * 512 + tid_, NT = gridDim.x * 512;
    constexpr int NQ = DFF / 4, NITEM = 24 * 2 * NQ;
    for (int it = gt; it < NITEM; it += NT) {
        const int q = it % NQ, wh = (it / NQ) & 1, bd = it / (2 * NQ);
        const int ch = q * 4, ucol = (ch >> 7) * 256 + (ch & 127);
        const int pm_lo = 16 + (bd / 3) * 4 + (bd % 3), pm_hi = pm_lo + 1;
        const float* h0; const float* h1; const float* h2; int row;
        if (wh == 0) { h0 = HALO + ((size_t)pm_lo * 4 + 2) * UPW; h1 = HALO + ((size_t)pm_lo * 4 + 3) * UPW; h2 = HALO + ((size_t)pm_hi * 4 + 0) * UPW; row = pm_lo * 256 + 255; }
        else         { h0 = HALO + ((size_t)pm_lo * 4 + 3) * UPW; h1 = HALO + ((size_t)pm_hi * 4 + 0) * UPW; h2 = HALO + ((size_t)pm_hi * 4 + 1) * UPW; row = pm_hi * 256; }
        f32x4 cv[2];
#pragma unroll
        for (int bj = 0; bj < 2; ++bj) {
            const int uc = ucol + bj * 128, wc_ = bj * DFF + ch;
            cv[bj] = (*(const f32x4*)(cw + wc_) * *(const f32x4*)(h0 + uc) + *(const f32x4*)(cw + UPW + wc_) * *(const f32x4*)(h1 + uc)
                   + *(const f32x4*)(cw + 2 * UPW + wc_) * *(const f32x4*)(h2 + uc)) * (1.f / S_WUP) + *(const f32x4*)(cb + wc_);
        }
        f32x4 r;
#pragma unroll
        for (int i = 0; i < 4; ++i) r[i] = cv[1][i] * __builtin_amdgcn_rcpf(1.f + __expf(-cv[1][i])) * cv[0][i] * S_ACT;
        if (DOWN_FP8) *(unsigned*)(ACT + (size_t)row * DFF + ch) = pk4_fp8(r.x, r.y, r.z, r.w);
        else *(u32x2*)(ACT + ((size_t)row * DFF + ch) * 2) = (u32x2){pg8::cvt_pk_bf16(r.x, r.y), pg8::cvt_pk_bf16(r.z, r.w)};
    }
}

constexpr int KPITCH = 72;
__device__ __forceinline__ void attn_unit(const Params& p, LAS unsigned char* lds, int l, int unit, int wv) {
    int tid_ = TID(wv); asm volatile("" : "+v"(tid_));
    const int tid = tid_, lane = tid & 63, w = tid >> 6, qi = lane & 31, hi = lane >> 5;
    const bool lat = unit < 256;
    int b, kvh, qb, T, seqrow0;
    if (lat) { b = unit >> 5; kvh = (unit >> 4) & 1; qb = unit & 15; T = LSEQ; seqrow0 = MCTX + b * LSEQ; }
    else { const int u = unit - 256; b = u >> 3; kvh = (u >> 2) & 1; qb = u & 3; T = SEQ; seqrow0 = b * SEQ; }
    const int jlo = lat ? (qb - 2 < 0 ? 0 : qb - 2) : 0, jhi = lat ? (qb + 2 > 15 ? 15 : qb + 2) : 3;
    const int nt = lat ? 4 + (jhi - jlo + 1) : 4;
    const bf16_t* Q = (const bf16_t*)(p.ws + WS_Q); const bf16_t* Kb = (const bf16_t*)(p.ws + WS_K); const bf16_t* VT = (const bf16_t*)(p.ws + WS_VT);
    const bf16_t* Kc = (const bf16_t*)(p.ws + WS_KC); const bf16_t* Vct = (const bf16_t*)(p.ws + WS_VCT);
    bf16_t* MIX = (bf16_t*)(p.ws + WS_MIX);
    const int g = w & 3, qh = w >> 2, head = kvh * 4 + g;
    const int qrow = seqrow0 + qb * 64 + qh * 32 + qi;
    const int qpos = qb * 64 + qh * 32 + qi;
    bf16x8 qf[4];
#pragma unroll
    for (int ks = 0; ks < 4; ++ks) qf[ks] = *(const bf16x8*)(Q + (size_t)qrow * 512 + head * 64 + ks * 16 + hi * 8);
    const float sink2 = p.in[I_SINK][l * 8 + head] * LOG2E;
    float mrun = sink2, lrun = 0.f;
    f32x16 o0, o1;
#pragma unroll
    for (int i = 0; i < 16; ++i) { o0[i] = 0.f; o1[i] = 0.f; }
    const bf16_t* vseq = lat ? VT + VT_LAT_OFF + (size_t)(b * 128 + kvh * 64) * LSEQ : VT + (size_t)(b * 128 + kvh * 64) * SEQ;
    const int sr = tid >> 3, sc8 = (tid & 7) * 8;
    u32x4 kreg, vreg;
#define ATT_LOAD(t) do { \
        if (lat && (t) < 4) { kreg = *(const u32x4*)(Kc + ((size_t)(l * NLAT + b) * PAST + (t) * 64 + sr) * 128 + kvh * 64 + sc8); \
                              vreg = *(const u32x4*)(Vct + ((size_t)((l * NLAT + b) * 2 + kvh) * 64 + sr) * PAST + (t) * 64 + sc8); } \
        else { const int jt_ = lat ? jlo + (t) - 4 : (t); \
               kreg = *(const u32x4*)(Kb + ((size_t)seqrow0 + jt_ * 64 + sr) * 128 + kvh * 64 + sc8); \
               vreg = *(const u32x4*)(vseq + (size_t)sr * T + jt_ * 64 + sc8); } } while (0)
#define ATT_STORE(buf) do { *(LAS u32x4*)(lds + ((buf) * 64 + sr) * (KPITCH * 2) + sc8 * 2) = kreg; \
                            *(LAS u32x4*)(lds + 18432 + ((buf) * 64 + sr) * (KPITCH * 2) + sc8 * 2) = vreg; } while (0)
    __syncthreads();
    ATT_LOAD(0); ATT_STORE(0);
    __syncthreads();
    for (int t = 0; t < nt; ++t) {
        const int buf = t & 1;
        if (t + 1 < nt) ATT_LOAD(t + 1);
        const LAS unsigned char* ks = lds + (buf * 64) * (KPITCH * 2);
        const LAS unsigned char* vs = lds + 18432 + (buf * 64) * (KPITCH * 2);
        f32x16 s0, s1;
#pragma unroll
        for (int i = 0; i < 16; ++i) { s0[i] = 0.f; s1[i] = 0.f; }
#pragma unroll
        for (int kk = 0; kk < 4; ++kk) {
            const bf16x8 a0 = *(const LAS bf16x8*)(ks + qi * (KPITCH * 2) + (kk * 16 + hi * 8) * 2);
            const bf16x8 a1 = *(const LAS bf16x8*)(ks + (32 + qi) * (KPITCH * 2) + (kk * 16 + hi * 8) * 2);
            s0 = __builtin_amdgcn_mfma_f32_32x32x16_bf16(a0, qf[kk], s0, 0, 0, 0);
            s1 = __builtin_amdgcn_mfma_f32_32x32x16_bf16(a1, qf[kk], s1, 0, 0, 0);
        }
        if (lat && t >= 4 && (jlo + t - 4 - qb == 2 || qb - (jlo + t - 4) == 2)) {
            const int kbase = (jlo + t - 4) * 64 + 4 * hi;
#pragma unroll
            for (int i = 0; i < 16; ++i) { const int kp = kbase + (i & 3) + 8 * (i >> 2); int d0 = qpos - kp; d0 = d0 < 0 ? -d0 : d0; int d1 = qpos - (kp + 32); d1 = d1 < 0 ? -d1 : d1;
                if (d0 > 128) s0[i] = -1e30f; if (d1 > 128) s1[i] = -1e30f; }
        }
        float mx = s0[0];
#pragma unroll
        for (int i = 1; i < 16; ++i) mx = fmaxf(mx, s0[i]);
#pragma unroll
        for (int i = 0; i < 16; ++i) mx = fmaxf(mx, s1[i]);
        mx = fmaxf(mx, shfl_xor_l(mx, lane, 32));
        const float mnew = fmaxf(mrun, mx), alpha = __builtin_amdgcn_exp2f(mrun - mnew);
        mrun = mnew;
        float ps = 0.f;
#pragma unroll
        for (int i = 0; i < 16; ++i) { s0[i] = __builtin_amdgcn_exp2f(s0[i] - mnew); s1[i] = __builtin_amdgcn_exp2f(s1[i] - mnew); ps += s0[i] + s1[i]; }
        lrun = lrun * alpha + ps;
#pragma unroll
        for (int i = 0; i < 16; ++i) { o0[i] *= alpha; o1[i] *= alpha; }
#pragma unroll
        for (int kb = 0; kb < 2; ++kb)
#pragma unroll
            for (int st = 0; st < 2; ++st) {
                bf16x8 pb;
                {
                    const f32x16& sx = kb == 0 ? s0 : s1;
                    const unsigned w0 = pg8::cvt_pk_bf16(sx[8 * st + 0], sx[8 * st + 1]), w1 = pg8::cvt_pk_bf16(sx[8 * st + 2], sx[8 * st + 3]);
                    const unsigned w2 = pg8::cvt_pk_bf16(sx[8 * st + 4], sx[8 * st + 5]), w3 = pg8::cvt_pk_bf16(sx[8 * st + 6], sx[8 * st + 7]);
                    pb = __builtin_bit_cast(bf16x8, (u32x4){w0, w1, w2, w3});
                }
                const int kcol = kb * 32 + 16 * st + 4 * hi;
                const u32x2 va0 = *(const LAS u32x2*)(vs + qi * (KPITCH * 2) + kcol * 2), va1 = *(const LAS u32x2*)(vs + qi * (KPITCH * 2) + (kcol + 8) * 2);
                const u32x2 vb0 = *(const LAS u32x2*)(vs + (32 + qi) * (KPITCH * 2) + kcol * 2), vb1 = *(const LAS u32x2*)(vs + (32 + qi) * (KPITCH * 2) + (kcol + 8) * 2);
                const bf16x8 va = __builtin_bit_cast(bf16x8, (u32x4){va0.x, va0.y, va1.x, va1.y});
                const bf16x8 vb = __builtin_bit_cast(bf16x8, (u32x4){vb0.x, vb0.y, vb1.x, vb1.y});
                o0 = __builtin_amdgcn_mfma_f32_32x32x16_bf16(va, pb, o0, 0, 0, 0);
                o1 = __builtin_amdgcn_mfma_f32_32x32x16_bf16(vb, pb, o1, 0, 0, 0);
            }
        if (t + 1 < nt) ATT_STORE(buf ^ 1);
        __syncthreads();
    }
#undef ATT_LOAD
#undef ATT_STORE
    const float ltot = lrun + shfl_xor_l(lrun, lane, 32) + __builtin_amdgcn_exp2f(sink2 - mrun);
    const float inv = 1.f / ltot;
    if (OUT_FP8) {
        unsigned char* op = (unsigned char*)MIX + (size_t)qrow * D + head * 64 + 4 * hi; const float is = inv * S_MIX;
#pragma unroll
        for (int gq = 0; gq < 4; ++gq) {
            *(unsigned*)(op + 8 * gq) = pk4_fp8(o0[4 * gq] * is, o0[4 * gq + 1] * is, o0[4 * gq + 2] * is, o0[4 * gq + 3] * is);
            *(unsigned*)(op + 32 + 8 * gq) = pk4_fp8(o1[4 * gq] * is, o1[4 * gq + 1] * is, o1[4 * gq + 2] * is, o1[4 * gq + 3] * is);
        }
    } else {
    bf16_t* op = MIX + (size_t)qrow * D + head * 64 + 4 * hi;
#pragma unroll
    for (int gq = 0; gq < 4; ++gq) {
        *(u32x2*)(op + 8 * gq) = (u32x2){pg8::cvt_pk_bf16(o0[4 * gq] * inv, o0[4 * gq + 1] * inv), pg8::cvt_pk_bf16(o0[4 * gq + 2] * inv, o0[4 * gq + 3] * inv)};
        *(u32x2*)(op + 32 + 8 * gq) = (u32x2){pg8::cvt_pk_bf16(o1[4 * gq] * inv, o1[4 * gq + 1] * inv), pg8::cvt_pk_bf16(o1[4 * gq + 2] * inv, o1[4 * gq + 3] * inv)};
    }
    }
}

__device__ __forceinline__ void pool_unit(const Params& p, int unit, int wv) {
    const float* PP = (const float*)(p.ws + WS_PP); bf16_t* MIX = (bf16_t*)(p.ws + WS_MIX);
    int tid_ = TID(wv); asm volatile("" : "+v"(tid_));
    const int cq = tid_ & 127, rs = tid_ >> 7, grp = cq >> 5, win = 2 << grp, half = win >> 1;
    const int row0 = unit * 64 + rs * 16;
    const int T = row0 < MCTX ? SEQ : LSEQ, t0 = row0 < MCTX ? (row0 & 255) : ((row0 - MCTX) & 1023), seq0 = row0 - t0;
    const float* base = PP + (size_t)seq0 * 512 + cq * 4;
    f32x4 sum = {0.f, 0.f, 0.f, 0.f};
#pragma unroll
    for (int k = 0; k < 16; ++k) { const int j = t0 - half + k; if (k < win && j >= 0 && j < T) sum += *(const f32x4*)(base + (size_t)j * 512); }
    f32x4 own[16], ent[16], lea[16];
#pragma unroll
    for (int i = 0; i < 16; ++i) { const int t = t0 + i; own[i] = *(const f32x4*)(base + (size_t)t * 512);
        ent[i] = (f32x4){0.f, 0.f, 0.f, 0.f}; lea[i] = (f32x4){0.f, 0.f, 0.f, 0.f};
        if (t + half < T) ent[i] = *(const f32x4*)(base + (size_t)(t + half) * 512);
        if (t - half >= 0) lea[i] = *(const f32x4*)(base + (size_t)(t - half) * 512); }
#pragma unroll
    for (int i = 0; i < 16; ++i) { const int t = t0 + i;
        const int s = t - half < 0 ? 0 : t - half, e = t + half > T ? T : t + half;
        const f32x4 d = sum * (1.f / (float)(e - s)) - own[i];
        if (OUT_FP8) *(unsigned*)((unsigned char*)MIX + (size_t)(seq0 + t) * D + 512 + cq * 4) = pk4_fp8(d.x * S_MIX, d.y * S_MIX, d.z * S_MIX, d.w * S_MIX);
        else *(u32x2*)(MIX + (size_t)(seq0 + t) * D + 512 + cq * 4) = (u32x2){pk2(d.x, d.y), pk2(d.z, d.w)};
        sum = sum + ent[i] - lea[i]; }
}

__global__ void __launch_bounds__(512, 2) mega_fwd(Params p) {
    extern __shared__ __attribute__((aligned(16))) unsigned char lds_raw[];
    LAS unsigned char* lds = (LAS unsigned char*)lds_raw;
    unsigned char* ws = p.ws;
    constexpr int G = 256;
    float* mods = (float*)(ws + WS_MODS);

#ifndef REP_SYNC
#define REP_SYNC 0
#endif
#ifndef REP_KIND
#define REP_KIND -2
#endif
    volatile LAS unsigned* xst = (volatile LAS unsigned*)(lds + 131072 + 64);
    unsigned* xbar = (unsigned*)(ws + WS_BAR);
    const int wv = __builtin_amdgcn_readfirstlane((int)threadIdx.x >> 6);
    if (wv == 0 && lane_id() == 0) { xst[0] = 0u; xst[1] = 0u; }
    __syncthreads();
    xcd_barrier_post(xbar, wv);
    prep_items(p, lds, wv, 0, PREP_MODS | PREP_FOLD | PREP_W0 | PREP_W1 | PREP_MISC, (int)blockIdx.x, G);
    __syncthreads();
    xcd_barrier(xbar, xst, wv);

#pragma unroll 1
    for (int ph = -1; ph < 6 * DEPTH; ++ph) {
        const int l = ph < 0 ? 0 : ph / 6, kind = ph < 0 ? -1 : ph % 6;
#pragma unroll 1
        for (int rep = (kind == REP_KIND ? 1 : 0); rep >= 0; --rep) {
        if (kind == -1) prologue_b(p, wv);
        else if (kind == 0) {
            pg8::Gemm g{(const bf16_t*)(ws + WS_H), (const bf16_t*)(ws + WS_WIN) + (size_t)l * INW * D, MTOT, INW, D};
            pg8::StaticOrder S; S.init(MTOT, INW, G, (int)blockIdx.x);
            EpiIn E{l, (bf16_t*)(ws + WS_Q), (bf16_t*)(ws + WS_K), (bf16_t*)(ws + WS_VT), (float*)(ws + WS_PP), (const float*)(ws + WS_ROPE),
                    p.out + (size_t)MTOT * D, p.out + (size_t)MTOT * D + (size_t)NCTX * DEPTH * SEQ * 128};
            pg8::gemm_phase<EpiIn, pg8::StaticOrder>(lds, g, S, E, wv);
        } else if (kind == 1) {
            for (int r = 0; r < 3; ++r) { const int u = r * G + (r == 2 ? (int)((blockIdx.x + G / 2) % G) : (int)blockIdx.x);
                if (u < 576) { if (u < 384) attn_unit(p, lds, l, u, wv); else pool_unit(p, u - 384, wv); } }
        } else if (kind == 2) {
            pg8::Gemm g{(const bf16_t*)(ws + WS_MIX), (const bf16_t*)(ws + WS_WOUT + (size_t)l * D * D * (OUT_FP8 ? 1 : 2)), MTOT, D, OUT_FP8 ? D / 2 : D};
            pg8::StaticOrder S; S.init(MTOT, D, G, (int)blockIdx.x);
            const float* ml = mods + (size_t)l * NCOND * MODW;
            EpiLn<OUT_FP8, UP_FP8> E{(float*)(ws + WS_X), ml + 2 * D, p.in[I_LN1G] + l * D, p.in[I_LN1B] + l * D, ml + 3 * D, ml + 4 * D, (bf16_t*)(ws + (UP_FP8 ? WS_H8 : WS_H)), nullptr, 1.f / (S_WOUT * S_MIX),
                    (unsigned long long*)(ws + WS_STATS), xbar + XCD_BAR_WORDS + (l * 2 + 0) * 64, xbar + XB_TMO, lds};
            pg8::gemm_phase<EpiLn<OUT_FP8, UP_FP8>, pg8::StaticOrder>(lds, g, S, E, wv);
            if (l + 1 < DEPTH) {
                if (G > 192) { if ((int)blockIdx.x >= 192) prep_items(p, lds, wv, l + 1, PREP_W0, (int)blockIdx.x - 192, G - 192); }
                else prep_items(p, lds, wv, l + 1, PREP_W0, (int)blockIdx.x, G);
            }
        } else if (kind == 3) {
            pg8::Gemm g{(const bf16_t*)(ws + (UP_FP8 ? WS_H8 : WS_H)), (const bf16_t*)(ws + WS_WUP + (size_t)l * UPW * D * (UP_FP8 ? 1 : 2)), MTOT, UPW, UP_FP8 ? D / 2 : D};
            pg8::StaticOrder S; S.init(MTOT, UPW, G, (int)blockIdx.x);
            EpiUpConv E{ws + WS_ACT, (float*)(ws + WS_HALO), p.in[I_CONVW] + (size_t)l * 3 * UPW, p.in[I_CONVB] + (size_t)l * UPW, lds};
            pg8::gemm_phase<EpiUpConv, pg8::StaticOrder>(lds, g, S, E, wv);
            if (l + 1 < DEPTH) prep_items(p, lds, wv, l + 1, PREP_MODS | PREP_FOLD, ((int)blockIdx.x + G - 32) % G, G);
        } else if (kind == 4) convfix_pass(p, l, wv);
        else {
            pg8::Gemm g{(const bf16_t*)(ws + WS_ACT), (const bf16_t*)(ws + WS_WDN + (size_t)l * D * DFF * (DOWN_FP8 ? 1 : 2)), MTOT, D, DOWN_FP8 ? DFF / 2 : DFF};
            pg8::StaticOrder S; S.init(MTOT, D, G, (int)blockIdx.x);
            const float* ml = mods + (size_t)l * NCOND * MODW; const float* mn = mods + (size_t)(l + 1 < DEPTH ? l + 1 : l) * NCOND * MODW;
            EpiLn<DOWN_FP8, false> E{(float*)(ws + WS_X), ml + 5 * D, p.in[I_LN2G] + l * D, p.in[I_LN2B] + l * D, mn, mn + D, (bf16_t*)(ws + WS_H), l + 1 < DEPTH ? nullptr : p.out, 1.f / (S_WDN * S_ACT),
                    (unsigned long long*)(ws + WS_STATS), xbar + XCD_BAR_WORDS + (l * 2 + 1) * 64, xbar + XB_TMO, lds};
            pg8::gemm_phase<EpiLn<DOWN_FP8, false>, pg8::StaticOrder>(lds, g, S, E, wv);
            if (l + 1 < DEPTH) {
                if (G > 192) { if ((int)blockIdx.x >= 192) prep_items(p, lds, wv, l + 1, PREP_W1, (int)blockIdx.x - 192, G - 192); }
                else prep_items(p, lds, wv, l + 1, PREP_W1, (int)blockIdx.x, G);
            }
        }
        __syncthreads();
        }
        if (ph + 1 < 6 * DEPTH) { xcd_barrier(xbar, xst, wv); if (REP_SYNC) xcd_barrier(xbar, xst, wv); }
    }
}

extern "C" void kernel_launch(void* const* d_in, const int* in_sizes, int n_in, void* d_out, int out_size, void* d_ws, size_t ws_size, hipStream_t stream) {
    static int grid_blocks = 0;
    if (grid_blocks == 0) {
        if (n_in != 21 || ws_size < WS_END) { fprintf(stderr, "kernel_launch: unexpected n_in %d / ws_size %zu (need %zu)\n", n_in, ws_size, (size_t)WS_END); grid_blocks = -1; return; }
        int dev = 0, cus = 0, per_cu = 0;
        hipGetDevice(&dev);
        hipDeviceGetAttribute(&cus, hipDeviceAttributeMultiprocessorCount, dev);
        hipFuncSetAttribute((const void*)mega_fwd, hipFuncAttributeMaxDynamicSharedMemorySize, LDS_BYTES);
        hipOccupancyMaxActiveBlocksPerMultiprocessor(&per_cu, (const void*)mega_fwd, 512, LDS_BYTES);
        if (per_cu < 1) { fprintf(stderr, "kernel_launch: occupancy query reports %d blocks per CU\n", per_cu); per_cu = 1; }
        if (per_cu > 1) per_cu = 1;
        grid_blocks = cus * per_cu;
        if (grid_blocks != 256) { fprintf(stderr, "kernel_launch: built for a 256-CU device (got %d workgroups)\n", grid_blocks); grid_blocks = -1; return; }
        (void)hipGetLastError();
    }
    if (grid_blocks < 0) return;
    Params p{};
    for (int i = 0; i < 21; ++i) p.in[i] = (const float*)d_in[i];
    p.out = (float*)d_out; p.ws = (unsigned char*)d_ws;
    (void)hipMemsetAsync((char*)d_ws + WS_BAR, 0, (XCD_BAR_WORDS + 512) * 4, stream);
    void* args[] = {&p};
    hipError_t e = hipLaunchCooperativeKernel((const void*)mega_fwd, dim3(grid_blocks), dim3(512), args, LDS_BYTES, stream);
    if (e != hipSuccess) fprintf(stderr, "cooperative launch failed: %s (grid %d)\n", hipGetErrorString(e), grid_blocks);
}
```
